# Optimizing an MI355X kernel written in HIP

```python
import jax
import jax.numpy as jnp
from jax import lax
import numpy as np

D_MODEL = 2048
BATCH = 8
SEQ = 4096
DEPTH = 2

GRID_W = 64
CTX_LEN = 256
N_BRANCH = 4
MIX_W = D_MODEL // 4
NA_HEADS = 8
NA_HEAD_DIM = MIX_W // NA_HEADS
NA_WIN_H = 8
NA_WIN_W = 16
NA_KBLK_W = 2 * NA_WIN_W
NA_NBLK = GRID_W // NA_WIN_W
NA_SCALE = NA_HEAD_DIM ** -0.5
CONV_WIDTH = 3
FOURIER_GROUPS = 4
POOL_WINDOWS = (2, 4, 8, 16)
POOL_GC = MIX_W // len(POOL_WINDOWS)
N_EXPERTS = 16
EXPERT_FF = D_MODEL
EC_CAPACITY = 2
N_MOD = 6
EPS = 1e-6
NEG_INF = -1e30

IN_SPLITS = tuple(MIX_W * i for i in range(1, 9))
IN_COLS = 8 * MIX_W + N_BRANCH * D_MODEL
K_OFF = 4 * MIX_W
V_END = 6 * MIX_W

kernel_name = 'hybrid_gated_mixers_ec_moe_diffusion'


def rmsnorm(x, w):
    xf = x.astype(jnp.float32)
    y = xf * lax.rsqrt(jnp.mean(xf * xf, axis=-1, keepdims=True) + EPS)
    return (y * w.astype(jnp.float32)).astype(x.dtype)


def modulate(h, shift, scale):
    return h * (1 + scale) + shift


def short_conv(u, w):
    return lax.conv_general_dilated(
        u, w[:, None, :].astype(u.dtype), window_strides=(1,),
        padding=((CONV_WIDTH // 2, CONV_WIDTH // 2),),
        dimension_numbers=('NWC', 'WIO', 'NWC'), feature_group_count=u.shape[-1])


def fourier_mix(u):
    b, n, _ = u.shape
    ug = u.astype(jnp.float32).reshape(b, n, FOURIER_GROUPS, MIX_W // FOURIER_GROUPS)
    y = jnp.fft.fftn(ug, axes=(1, 3), norm='ortho').real
    return y.reshape(b, n, MIX_W).astype(u.dtype)


def multiscale_pool(u, w_grp, scale):
    b, n, _ = u.shape
    ng = len(POOL_WINDOWS)
    uf = u.astype(jnp.float32).reshape(b, n, ng, POOL_GC)
    csum = jnp.concatenate([jnp.zeros((b, 1, ng, POOL_GC), jnp.float32), lax.cumsum(uf, axis=1)], axis=1)
    t = np.arange(n)[:, None]
    win = np.asarray(POOL_WINDOWS)[None, :]
    lo = np.clip(t - win // 2, 0, n - 1)
    hi = np.clip(t + win - win // 2 - 1, 0, n - 1)
    gi = np.arange(ng)[None, :]
    count = (hi - lo + 1).astype(np.float32)[None, :, :, None]
    pooled = (csum[:, hi + 1, gi] - csum[:, lo, gi]) / count - uf
    y = jnp.einsum('bngc,gcd->bngd', pooled.astype(u.dtype), w_grp)
    return y.reshape(b, n, MIX_W) * scale


def na_tables(rows):
    kh = min(NA_WIN_H, rows)
    r = np.arange(rows)
    row_start = np.clip(r - kh // 2, 0, rows - kh)
    key_rows = row_start[:, None] + np.arange(kh)[None, :]
    dr = key_rows - r[:, None] + (NA_WIN_H - 1)
    qcol = np.arange(GRID_W).reshape(NA_NBLK, NA_WIN_W)
    kb_start = np.clip(np.arange(NA_NBLK) * NA_WIN_W - NA_WIN_W // 2, 0, GRID_W - NA_KBLK_W)
    key_cols = kb_start[:, None] + np.arange(NA_KBLK_W)[None, :]
    col_start = np.clip(qcol - NA_WIN_W // 2, 0, GRID_W - NA_WIN_W)
    kc = key_cols[:, None, :]
    cs = col_start[:, :, None]
    col_ok = (kc >= cs) & (kc < cs + NA_WIN_W)
    dc = np.clip(kc - qcol[:, :, None] + (NA_WIN_W - 1), 0, 2 * NA_WIN_W - 2)
    return kh, key_rows, key_cols, col_ok, dr, dc


def neighbourhood_attention(q, k, v, k_ctx, v_ctx, rpb):
    b, n, nh, dh = q.shape
    rows = n // GRID_W
    kh, key_rows, key_cols, col_ok, dr, dc = na_tables(rows)
    nkeys = kh * NA_KBLK_W
    qb = q.reshape(b, rows, NA_NBLK, NA_WIN_W, nh, dh)
    kg = k.reshape(b, rows, GRID_W, nh, dh)
    vg = v.reshape(b, rows, GRID_W, nh, dh)
    ri = key_rows[:, None, :, None]
    ci = key_cols[None, :, None, :]
    kb = kg[:, ri, ci]
    vb = vg[:, ri, ci]
    s_loc = jnp.einsum('brnqhd,brnijhd->bhrnqij', qb, kb, preferred_element_type=jnp.float32) * NA_SCALE
    bias = rpb[:, dr[:, None, None, :, None], dc[None, :, :, None, :]].astype(jnp.float32)
    s_loc = jnp.where(col_ok[:, :, None, :], s_loc + bias, NEG_INF)
    s_ctx = jnp.einsum('brnqhd,blhd->bhrnql', qb, k_ctx, preferred_element_type=jnp.float32) * NA_SCALE
    s = jnp.concatenate([s_loc.reshape(b, nh, rows, NA_NBLK, NA_WIN_W, nkeys), s_ctx], axis=-1)
    p = jax.nn.softmax(s, axis=-1).astype(v.dtype)
    p_loc = p[..., :nkeys].reshape(b, nh, rows, NA_NBLK, NA_WIN_W, kh, NA_KBLK_W)
    o = (jnp.einsum('bhrnqij,brnijhd->brnqhd', p_loc, vb)
         + jnp.einsum('bhrnql,blhd->brnqhd', p[..., nkeys:], v_ctx))
    return o.reshape(b, n, nh * dh)


def context_attention(q, k, v):
    b, l, nh, dh = q.shape
    s = jnp.einsum('blhd,bmhd->bhlm', q, k, preferred_element_type=jnp.float32) * NA_SCALE
    p = jax.nn.softmax(s, axis=-1).astype(v.dtype)
    return jnp.einsum('bhlm,bmhd->blhd', p, v).reshape(b, l, nh * dh)


def kv_heads(zk, zv, k_norm_w):
    b, n, _ = zk.shape
    k = rmsnorm(zk.reshape(b, n, NA_HEADS, NA_HEAD_DIM), k_norm_w)
    v = zv.reshape(b, n, NA_HEADS, NA_HEAD_DIM)
    return k, v


def token_mixer(z, kv_ctx, is_latent, conv_w, q_norm_w, k_norm_w, rpb, pool_w, pool_scale, w_branch, w_out):
    b, n, _ = z.shape
    xa, gb, gc, zq, zk, zv, zf, zp, zg = jnp.split(z, IN_SPLITS, axis=-1)
    y_conv = gb * short_conv(gc * xa, conv_w)
    q = rmsnorm(zq.reshape(b, n, NA_HEADS, NA_HEAD_DIM), q_norm_w)
    if is_latent:
        k, v = kv_heads(zk, zv, k_norm_w)
        y_att = neighbourhood_attention(q, k, v, kv_ctx[0], kv_ctx[1], rpb)
    else:
        y_att = context_attention(q, kv_ctx[0], kv_ctx[1])
    branches = (y_conv, y_att, fourier_mix(zf), multiscale_pool(zp, pool_w, pool_scale))
    gates = jax.nn.sigmoid(zg.reshape(b, n, N_BRANCH, D_MODEL))
    merged = gates[:, :, 0] * (branches[0] @ w_branch[0])
    for i in range(1, N_BRANCH):
        merged = merged + gates[:, :, i] * (branches[i] @ w_branch[i])
    return merged @ w_out


def expert_choice_ffn(h, w_router, w_gate, w_up, w_down):
    b, n, _ = h.shape
    cap = EC_CAPACITY * n // N_EXPERTS
    logits = jnp.einsum('bnd,de->ben', h, w_router, preferred_element_type=jnp.float32)
    affinity = jax.nn.softmax(logits, axis=1)
    gate, idx = lax.top_k(affinity, cap)
    bi = jnp.arange(b)[:, None, None]
    xs = h[bi, idx]
    a = jnp.einsum('becd,edf->becf', xs, w_gate)
    u = jnp.einsum('becd,edf->becf', xs, w_up)
    y = jnp.einsum('becf,efd->becd', jax.nn.silu(a) * u, w_down) * gate[..., None].astype(h.dtype)
    return jnp.zeros_like(h).at[bi, idx].add(y)


def setup_inputs(seed: int = 0) -> dict:
    key = jax.random.key(seed)
    ks = jax.random.split(key, 21)
    f32 = jnp.float32

    def nrm(k, shape, s):
        return jax.random.normal(k, shape, f32) * s

    return {
        'x': nrm(ks[0], (BATCH, SEQ, D_MODEL), 1.0),
        'c': nrm(ks[1], (BATCH, D_MODEL), 1.0),
        'ctx': nrm(ks[2], (BATCH, CTX_LEN, D_MODEL), 1.0),
        'c_ctx': nrm(ks[3], (D_MODEL,), 1.0),
        'w_ada': nrm(ks[4], (DEPTH, D_MODEL, N_MOD * D_MODEL), 0.5 * D_MODEL ** -0.5),
        'b_ada': nrm(ks[5], (DEPTH, N_MOD * D_MODEL), 0.02),
        'norm1_w': 1.0 + nrm(ks[6], (DEPTH, D_MODEL), 0.02),
        'norm2_w': 1.0 + nrm(ks[7], (DEPTH, D_MODEL), 0.02),
        'w_in': nrm(ks[8], (DEPTH, D_MODEL, IN_COLS), D_MODEL ** -0.5),
        'conv_w': nrm(ks[9], (DEPTH, CONV_WIDTH, MIX_W), CONV_WIDTH ** -0.5),
        'q_norm_w': 1.0 + nrm(ks[10], (DEPTH, NA_HEAD_DIM), 0.02),
        'k_norm_w': 1.0 + nrm(ks[11], (DEPTH, NA_HEAD_DIM), 0.02),
        'na_rpb': nrm(ks[12], (DEPTH, NA_HEADS, 2 * NA_WIN_H - 1, 2 * NA_WIN_W - 1), 0.1),
        'pool_w': nrm(ks[13], (DEPTH, len(POOL_WINDOWS), POOL_GC, POOL_GC), POOL_GC ** -0.5),
        'pool_scale': 1.0 + nrm(ks[14], (DEPTH, MIX_W), 0.1),
        'w_branch': nrm(ks[15], (DEPTH, N_BRANCH, MIX_W, D_MODEL), MIX_W ** -0.5),
        'w_out': nrm(ks[16], (DEPTH, D_MODEL, D_MODEL), D_MODEL ** -0.5),
        'w_router': nrm(ks[17], (DEPTH, D_MODEL, N_EXPERTS), D_MODEL ** -0.5),
        'w_exp_gate': nrm(ks[18], (DEPTH, N_EXPERTS, D_MODEL, EXPERT_FF), D_MODEL ** -0.5),
        'w_exp_up': nrm(ks[19], (DEPTH, N_EXPERTS, D_MODEL, EXPERT_FF), D_MODEL ** -0.5),
        'w_exp_down': nrm(ks[20], (DEPTH, N_EXPERTS, EXPERT_FF, D_MODEL), EXPERT_FF ** -0.5),
    }


def reference(x, c, ctx, c_ctx, w_ada, b_ada, norm1_w, norm2_w, w_in, conv_w, q_norm_w, k_norm_w,
              na_rpb, pool_w, pool_scale, w_branch, w_out, w_router, w_exp_gate, w_exp_up, w_exp_down):
    sc = jax.nn.silu(c)
    scc = jax.nn.silu(c_ctx)
    for l in range(DEPTH):
        last = l == DEPTH - 1
        mod = (sc @ w_ada[l] + b_ada[l])[:, None, :]
        sh1, sc1, g1, sh2, sc2, g2 = jnp.split(mod, N_MOD, axis=-1)
        n_cols = (2 if last else N_MOD) * D_MODEL
        mod_c = jnp.split(scc @ w_ada[l][:, :n_cols] + b_ada[l][:n_cols], n_cols // D_MODEL)
        hc = modulate(rmsnorm(ctx, norm1_w[l]), mod_c[0], mod_c[1])
        if last:
            zkv = hc @ w_in[l][:, K_OFF:V_END]
        else:
            zc = hc @ w_in[l]
            zkv = zc[..., K_OFF:V_END]
        kv_c = kv_heads(zkv[..., :MIX_W], zkv[..., MIX_W:], k_norm_w[l])
        mixer_p = (conv_w[l], q_norm_w[l], k_norm_w[l], na_rpb[l], pool_w[l], pool_scale[l], w_branch[l], w_out[l])
        ffn_p = (w_router[l], w_exp_gate[l], w_exp_up[l], w_exp_down[l])
        h = modulate(rmsnorm(x, norm1_w[l]), sh1, sc1)
        x = x + g1 * token_mixer(h @ w_in[l], kv_c, True, *mixer_p)
        h = modulate(rmsnorm(x, norm2_w[l]), sh2, sc2)
        x = x + g2 * expert_choice_ffn(h, *ffn_p)
        if not last:
            ctx = ctx + mod_c[2] * token_mixer(zc, kv_c, False, *mixer_p)
            hc2 = modulate(rmsnorm(ctx, norm2_w[l]), mod_c[3], mod_c[4])
            ctx = ctx + mod_c[5] * expert_choice_ffn(hc2, *ffn_p)
    return x
```

```cpp
#include <hip/hip_runtime.h>
#include <cstdio>
#include <cstdint>

#define LAS __attribute__((address_space(3)))
#define GAS __attribute__((address_space(1)))
typedef unsigned short bf16;
typedef short bf16x8 __attribute__((ext_vector_type(8)));
typedef short s16x4 __attribute__((ext_vector_type(4)));
typedef float f32x4 __attribute__((ext_vector_type(4)));
typedef float f32x2 __attribute__((ext_vector_type(2)));
typedef unsigned u32x4 __attribute__((ext_vector_type(4)));
typedef unsigned u32x2 __attribute__((ext_vector_type(2)));

#ifndef N_LAUNCH_MODE
#define N_LAUNCH_MODE 1
#endif

constexpr int D = 2048, NB = 8, SEQ = 4096, LC = 256, DEPTH = 2;
constexpr int ML = NB * SEQ, MC = NB * LC, MT = ML + MC;
constexpr int MIXW = 512, NH = 8, HD = 64, NE = 16, FF = 2048;
constexpr int INC = 12288;
constexpr int NZT = 50, NZ = NZT * 256;
constexpr int CAPL = 512, CAPC = 32, RPE = NB * CAPL + NB * CAPC;
constexpr int PPE = RPE / 256;
constexpr float EPS = 1e-6f;
constexpr float LOG2E = 1.4426950408889634f;
constexpr int NPHASE = 24;

constexpr size_t al(size_t x) { return (x + 4095) & ~(size_t)4095; }
constexpr size_t WS_CTL = 0, CTL_BYTES = 1u << 20;
constexpr size_t WS_MOD = CTL_BYTES, MOD_BYTES = al((size_t)DEPTH * 9 * 6 * D * 4);
constexpr size_t ZERO_BYTES = WS_MOD + MOD_BYTES;
constexpr size_t WS_WIN = ZERO_BYTES, SZ_WIN = (size_t)NZ * D * 2;
constexpr size_t WS_WBR = WS_WIN + SZ_WIN, SZ_WBR = (size_t)D * D * 2;
constexpr size_t WS_WOUT = WS_WBR + SZ_WBR, SZ_WOUT = (size_t)D * D * 2;
constexpr size_t WS_WGU = WS_WOUT + SZ_WOUT, SZ_WGU = (size_t)NE * 2 * FF * D * 2;
constexpr size_t WS_WD = WS_WGU + SZ_WGU, SZ_WD = (size_t)NE * D * FF * 2;
constexpr size_t WS_DFTC = WS_WD + SZ_WD, SZ_DFTC = (size_t)LC * 2 * LC * 2;
constexpr size_t WS_H = WS_DFTC + SZ_DFTC, SZ_H = (size_t)MT * D * 2;
constexpr size_t WS_H8 = WS_H + SZ_H, SZ_H8 = (size_t)MT * D;
constexpr size_t WS_WG8 = WS_H8 + SZ_H8, SZ_WG8 = (size_t)8192 * D;
constexpr size_t WS_WQKV8 = WS_WG8 + SZ_WG8, SZ_WQKV8 = (size_t)6 * 256 * D;
constexpr size_t WS_XC = WS_WQKV8 + SZ_WQKV8, SZ_XC = (size_t)MC * D * 4;
constexpr size_t WS_AFF = WS_XC + SZ_XC, SZ_AFF = (size_t)16 * NE * SEQ * 4;
constexpr size_t WS_GSL = WS_AFF + SZ_AFF, SZ_GSL = al((size_t)NE * RPE * 4);
constexpr size_t WS_SROW = WS_GSL + SZ_GSL, SZ_SROW = al((size_t)NE * RPE * 4);
constexpr size_t WS_INV = WS_SROW + SZ_SROW, SZ_INV = al((size_t)MT * NE * 2);
constexpr size_t WS_R1 = WS_INV + SZ_INV;
constexpr size_t SZ_PB = (size_t)MT * 8192 * 2, SZ_HID = (size_t)NE * RPE * D;
constexpr size_t WS_PB = WS_R1, WS_HID = WS_R1;
constexpr size_t SZ_R1 = SZ_PB > SZ_HID ? SZ_PB : SZ_HID;
constexpr size_t WS_R2 = WS_R1 + SZ_R1;
constexpr size_t SZ_T512 = (size_t)MT * 512 * 2;
constexpr size_t WS_P = WS_R2, WS_GB = WS_P + SZ_T512, WS_Q = WS_GB + SZ_T512, WS_KB = WS_Q + SZ_T512, WS_ZP = WS_KB + SZ_T512;
constexpr size_t WS_VT = WS_ZP + SZ_T512, SZ_VT = (size_t)NB * NH * HD * SEQ * 2, WS_VTC = WS_VT + SZ_VT, SZ_VTC = (size_t)NB * NH * HD * LC * 2;
constexpr size_t WS_TT = WS_VTC + SZ_VTC, SZ_TT = (size_t)NB * 512 * 2 * SEQ * 2, WS_TTC = WS_TT + SZ_TT, SZ_TTC = (size_t)NB * 512 * 2 * LC * 2;
constexpr size_t WS_BR = WS_TTC + SZ_TTC, SZ_BR = (size_t)MT * D * 2, WS_MG = WS_BR + SZ_BR;
constexpr size_t WS_Y = WS_R2, SZ_Y = (size_t)NE * RPE * D * 2;
constexpr size_t WS_S2 = WS_MG + SZ_BR, SZ_S2 = (size_t)NB * 64 * 512 * 128 * 2;
constexpr size_t WS_END = WS_S2 + SZ_S2;
static_assert(WS_Y + SZ_Y <= WS_END, "Y overlay");
static_assert(WS_END < (size_t)2250 * 1024 * 1024, "workspace budget");

constexpr int RING_BYTES = 131072, MISC_OFF = RING_BYTES, IDX_OFF = MISC_OFF + 1024, LDS_BYTES = 163840;

typedef __bf16 bf16x2_t __attribute__((ext_vector_type(2)));
__device__ __forceinline__ unsigned cvt_pk(float lo, float hi) { const f32x2 v = {lo, hi}; const bf16x2_t b = __builtin_convertvector(v, bf16x2_t); return __builtin_bit_cast(unsigned, b); }
__device__ __forceinline__ bf16 f2bf(float f) { const __bf16 b = (__bf16)f; return __builtin_bit_cast(unsigned short, b); }
__device__ __forceinline__ float bflo(unsigned u) { return __uint_as_float(u << 16); }
__device__ __forceinline__ float bfhi(unsigned u) { return __uint_as_float(u & 0xffff0000u); }
__device__ __forceinline__ int lane_now() { int l; asm volatile("v_mbcnt_lo_u32_b32 %0, -1, 0\n\tv_mbcnt_hi_u32_b32 %0, -1, %0" : "=v"(l)); return l; }
__device__ __forceinline__ float shx(float v, int o) { return __builtin_bit_cast(float, __builtin_amdgcn_ds_bpermute((lane_now() ^ o) << 2, __builtin_bit_cast(int, v))); }
__device__ __forceinline__ float wave_sum(float v) {
#pragma unroll
    for (int o = 1; o < 64; o <<= 1) v += shx(v, o);
    return v;
}
__device__ __forceinline__ float fast_rcp(float x) { return __builtin_amdgcn_rcpf(x); }
__device__ __forceinline__ float sigmoidf_(float x) { return fast_rcp(1.0f + __builtin_amdgcn_exp2f(-x * LOG2E)); }
__device__ __forceinline__ float siluf_(float x) { return x * sigmoidf_(x); }
constexpr float W8SCALE = 64.0f;
__device__ __forceinline__ float clamp8(float x) { return fminf(fmaxf(x, -448.0f), 448.0f); }
__device__ __forceinline__ unsigned cvt4_fp8(float a, float b, float c, float d) { int w = 0; w = __builtin_amdgcn_cvt_pk_fp8_f32(clamp8(a), clamp8(b), w, false); w = __builtin_amdgcn_cvt_pk_fp8_f32(clamp8(c), clamp8(d), w, true); return (unsigned)w; }
#define LDS_WAIT() asm volatile("s_waitcnt lgkmcnt(0)" ::: "memory")
__device__ __forceinline__ int fresh_tid(int wave) { int lane; asm volatile("v_mbcnt_lo_u32_b32 %0, -1, 0\n\tv_mbcnt_hi_u32_b32 %0, -1, %0" : "=v"(lane)); return wave * 64 + lane; }

#define XB_TMO      128
#define XB_XCNT(j)  (256  + 64 * (j))
#define XB_XSUB(j)  (1280 + 64 * (j))
#define XB_XGEN(j)  (2304 + 64 * (j))
#define XB_TOP      3328
#define XB_TOPGEN   3392
#define XCD_BAR_WORDS 3456
#define XB_SPIN_CAP (1u << 22)
__device__ __forceinline__ unsigned xb_ld(unsigned* p)              { return __hip_atomic_load(p, __ATOMIC_RELAXED, __HIP_MEMORY_SCOPE_AGENT); }
__device__ __forceinline__ unsigned xb_add(unsigned* p, unsigned v) { return __hip_atomic_fetch_add(p, v, __ATOMIC_RELAXED, __HIP_MEMORY_SCOPE_AGENT); }
__device__ __forceinline__ unsigned xb_xcc_id() { return (unsigned)__builtin_amdgcn_s_getreg((3 << 11) | 20) & 0xFu; }
#define XB_SPIN(cond, bar) do { unsigned _sp = 0; while (cond) { __builtin_amdgcn_s_sleep(1); \
    if ((++_sp & 255u) == 0u) { if (xb_ld(&(bar)[XB_TMO])) break; if (_sp > XB_SPIN_CAP) { atomicAdd(&(bar)[XB_TMO], 1u); break; } } } } while (0)
struct XcdBarrier { unsigned* bar; unsigned x; volatile LAS unsigned* st; };
__device__ __forceinline__ XcdBarrier xcd_barrier_post(unsigned* bar, volatile LAS unsigned* st) {
    XcdBarrier b; b.bar = bar; b.x = xb_xcc_id(); b.st = st;
    if (threadIdx.x == 0) (void)xb_add(&bar[XB_XCNT(b.x)], 1u);
    return b;
}
__device__ __forceinline__ void xcd_barrier_complete(unsigned* bar, unsigned x, unsigned& nloc, unsigned& nx) {
    const unsigned G = gridDim.x * gridDim.y * gridDim.z;
    unsigned sum, cnt, mine, sp = 0u;
    for (;;) {
        sum = 0u; cnt = 0u; mine = 0u;
        unsigned cs[16];
#pragma unroll
        for (unsigned j = 0; j < 16; ++j) cs[j] = __hip_atomic_load((const GAS unsigned*)&bar[XB_XCNT(j)], __ATOMIC_RELAXED, __HIP_MEMORY_SCOPE_AGENT);
#pragma unroll
        for (unsigned j = 0; j < 16; ++j) { const unsigned c = cs[j]; sum += c; cnt += (c > 0u) ? 1u : 0u; mine = (j == x) ? c : mine; }
        if (sum == G) break;
        __builtin_amdgcn_s_sleep(1);
        if ((++sp & 255u) == 0u) { if (xb_ld(&bar[XB_TMO])) break; if (sp > XB_SPIN_CAP) { atomicAdd(&bar[XB_TMO], 1u); break; } }
    }
    nloc = mine > 0u ? mine : 1u; nx = cnt > 0u ? cnt : 1u;
}
__device__ __forceinline__ void xcd_barrier(const XcdBarrier& b, int wave) {
    asm volatile("s_waitcnt vmcnt(0)" ::: "memory");
    __syncthreads();
    if (fresh_tid(wave) == 0) {
        unsigned* bar = b.bar; asm volatile("" : "+s"(bar));
        unsigned bx = xb_xcc_id(); asm volatile("" : "+s"(bx));
        __builtin_amdgcn_s_waitcnt(0);
        unsigned nloc = b.st[0], nx = b.st[1];
        if (nloc == 0u) { xcd_barrier_complete(bar, bx, nloc, nx); b.st[0] = nloc; b.st[1] = nx; }
        const unsigned old = xb_add(&bar[XB_XSUB(bx)], 1u);
        const unsigned gen = old / nloc;
        if (old + 1u == (gen + 1u) * nloc) {
            __builtin_amdgcn_fence(__ATOMIC_RELEASE, "agent");
            asm volatile("s_waitcnt vmcnt(0)" ::: "memory");
            const unsigned og = xb_add(&bar[XB_TOP], 1u);
            const unsigned tg = og / nx;
            if (og + 1u == (tg + 1u) * nx) xb_add(&bar[XB_TOPGEN], 1u);
            else XB_SPIN(xb_ld(&bar[XB_TOPGEN]) == tg, bar);
            __builtin_amdgcn_fence(__ATOMIC_ACQUIRE, "agent");
            xb_add(&bar[XB_XGEN(bx)], 1u);
            asm volatile("s_waitcnt vmcnt(0)" ::: "memory");
        } else {
            XB_SPIN(xb_ld(&bar[XB_XGEN(bx)]) == gen, bar);
            __builtin_amdgcn_fence(__ATOMIC_ACQUIRE, "agent");
            asm volatile("s_waitcnt vmcnt(0)" ::: "memory");
        }
    }
    __syncthreads();
}

#ifndef PG8_SP2_DEFAULT
#define PG8_SP2_DEFAULT true
#endif
namespace pg8 {
constexpr int BM = 256, BK = 64, HALF = 128, HTB = HALF * BK * 2, STAGE_BYTES = 8 * HTB;
__host__ __device__ __forceinline__ int lds_byte(int r, int c) { const int st = (r >> 4) * 2 + (c >> 5), rr = r & 15, cc = c & 31, ob = rr * 64 + cc * 2; return st * 1024 + (ob ^ (((ob >> 9) & 1) << 5)); }
__host__ __device__ __forceinline__ void stage_rc(int b, int& R, int& C) { const int st = b / 1024, sb = b % 1024, swz = sb ^ (((sb >> 9) & 1) << 5); R = (st >> 1) * 16 + swz / 64; C = (st & 1) * 32 + (swz % 64) / 2; }
__host__ __device__ __forceinline__ int perm32(int rho) { const int n = rho >> 4, i = rho & 15; return 8 * (i >> 2) + 4 * n + (i & 3); }
struct Unit { int pm, pn, am, bn, kofs; };
struct Geo { const void* A; const void* Bt; int Kb; int lda, ldb; const int* arows; };
typedef int i32x8 __attribute__((ext_vector_type(8)));
typedef int i32x4_ __attribute__((ext_vector_type(4)));

template <class Epi, class Sched, bool ALIGN_EPI, bool FP8 = false, bool APERM = false, bool AGATHER = false, bool SP2 = PG8_SP2_DEFAULT>
__device__ __forceinline__ void gemm_phase(LAS unsigned char* lds, int wave, const Geo g, const Sched& S, const Epi& E) {
    const int tid = fresh_tid(wave), wid = wave, lane = tid & 63, wr = wid >> 2, wc = wid & 3, fr = lane & 15, fq = lane >> 4;
    const int nt = g.Kb / 128;
    unsigned voffA[2], voffB[2]; int gR[2], gC[2];
#pragma unroll
    for (int i = 0; i < 2; ++i) { int R, C; stage_rc(tid * 16 + i * 8192, R, C); gR[i] = R; gC[i] = C * 2; const int Rb = Epi::PERM ? ((R & ~31) + perm32(R & 31)) : R;
        const int Ra = APERM ? 64 * (R >> 2) + (R & 3) : R;
        voffA[i] = (unsigned)(Ra * g.lda + C * 2); voffB[i] = (unsigned)(Rb * g.ldb + C * 2); }
    const size_t kstep = (size_t)(BK * 2);
    const size_t hstepA = AGATHER ? 0 : (size_t)(APERM ? 2048 : HALF) * g.lda, hstepB = (size_t)HALF * g.ldb;
    const size_t tstepA = AGATHER ? 0 : (APERM ? (size_t)4 * g.lda : 2 * hstepA), tstepB = 2 * hstepB;
    const unsigned ldsw = (unsigned)wid * 1024u;
    const int aoff = lds_byte(wr * 64 + fr, fq * 8), boff = lds_byte(wc * 32 + fr, fq * 8);
#define PG8_SA(b, h) (((b) * 2 + (h)) * HTB)
#define PG8_SB(b, h) ((4 + (b) * 2 + (h)) * HTB)
#define PG8_STAGE(bufoff, gbase, voff) do { _Pragma("unroll") for (int _i = 0; _i < 2; ++_i) \
        __builtin_amdgcn_global_load_lds((const unsigned*)((const char*)(gbase) + (voff)[_i]), (LAS unsigned*)(lds + (bufoff) + ldsw + _i * 8192), 16, 0, 0); } while (0)
#define PG8_LDA(dst, b, h) do { _Pragma("unroll") for (int m = 0; m < 4; ++m) _Pragma("unroll") for (int k = 0; k < 2; ++k) dst[m][k] = *(const LAS bf16x8*)(lds + PG8_SA(b, h) + aoff + m * 2048 + k * 1024); } while (0)
#define PG8_LDB(dst, b, h) do { _Pragma("unroll") for (int n = 0; n < 2; ++n) _Pragma("unroll") for (int k = 0; k < 2; ++k) dst[n][k] = *(const LAS bf16x8*)(lds + PG8_SB(b, h) + boff + n * 2048 + k * 1024); } while (0)
#define PG8_CAT(x) __builtin_shufflevector(__builtin_bit_cast(i32x4_, (x)[0]), __builtin_bit_cast(i32x4_, (x)[1]), 0, 1, 2, 3, 4, 5, 6, 7)
#define PG8_MMA(ai, bj, At, Bt) do { __builtin_amdgcn_s_setprio(1); _Pragma("unroll") for (int m = 0; m < 4; ++m) _Pragma("unroll") for (int n = 0; n < 2; ++n) { \
        if constexpr (FP8) { const i32x8 a8_ = PG8_CAT(Bt[n]), b8_ = PG8_CAT(At[m]); asm volatile("v_mfma_f32_16x16x128_f8f6f4 %0, %1, %2, %0" : "+v"(acc[ai][bj][m][n]) : "v"(a8_), "v"(b8_)); } \
        else { _Pragma("unroll") for (int k = 0; k < 2; ++k) acc[ai][bj][m][n] = __builtin_amdgcn_mfma_f32_16x16x32_bf16(Bt[n][k], At[m][k], acc[ai][bj][m][n], 0, 0, 0); } } \
        __builtin_amdgcn_s_setprio(0); } while (0)
#define PG8_WAIT_V(n) asm volatile("s_waitcnt vmcnt(" #n ")" ::: "memory")
#define PG8_W8E_ASM(N) asm volatile("s_cmp_lg_u32 %0, 0\n\ts_cbranch_scc0 .Lw8_%=\n\ts_waitcnt vmcnt(" #N ")\n\ts_branch .Lwe_%=\n.Lw8_%=:\n\ts_waitcnt vmcnt(8)\n.Lwe_%=:" :: "s"(fz) : "scc", "memory")
#define PG8_WAIT_V8E() do { if constexpr (Epi::NSTH == 16) PG8_W8E_ASM(24); else if constexpr (Epi::NSTH == 8) PG8_W8E_ASM(16); else if constexpr (Epi::NSTH == 4) PG8_W8E_ASM(12); \
        else if constexpr (Epi::NSTH == 2) PG8_W8E_ASM(10); else asm volatile("s_waitcnt vmcnt(8)" ::: "memory"); } while (0)
#define PG8_WAIT_L(n) asm volatile("s_waitcnt lgkmcnt(" #n ")" ::: "memory")
#define PG8_BAR __builtin_amdgcn_s_barrier()
#define PG8_SCHED __builtin_amdgcn_sched_barrier(0)
    Unit cur, nxt; int ui = 0;
    if (!S.next(0, cur)) return;
    LAS int* idxl = (LAS int*)(lds + IDX_OFF);
    unsigned vA[2][2], vN[2][2];
    if constexpr (AGATHER) {
        Unit uu;
        {
            int av[18]; unsigned okm = 0u;
#pragma unroll
            for (int i = 0; i < 18; ++i) { const bool ok = S.next(i, uu); av[i] = (ok && tid < 256) ? g.arows[uu.am * 256 + tid] : 0; okm |= ok ? (1u << i) : 0u; }
#pragma unroll
            for (int i = 0; i < 18; ++i) if (((okm >> i) & 1u) && tid < 256) idxl[i * 256 + tid] = av[i];
            if (okm >> 17) for (int i = 18; S.next(i, uu); ++i) if (tid < 256) idxl[i * 256 + tid] = g.arows[uu.am * 256 + tid];
        }
        __syncthreads();
#pragma unroll
        for (int h = 0; h < 2; ++h)
#pragma unroll
            for (int i = 0; i < 2; ++i) vA[h][i] = (unsigned)(idxl[h * 128 + gR[i]] * g.lda + gC[i]);
    } else {
#pragma unroll
        for (int h = 0; h < 2; ++h)
#pragma unroll
            for (int i = 0; i < 2; ++i) { vA[h][i] = voffA[i]; vN[h][i] = voffA[i]; }
    }
    f32x4 acc[2][2][4][2];
#pragma unroll
    for (int a = 0; a < 2; ++a)
#pragma unroll
        for (int b = 0; b < 2; ++b)
#pragma unroll
            for (int m = 0; m < 4; ++m)
#pragma unroll
                for (int n = 0; n < 2; ++n) acc[a][b][m][n] = (f32x4){0.f, 0.f, 0.f, 0.f};
    bf16x8 At[4][2], B0[2][2], B1[2][2];
    const char* cA = (const char*)g.A + (size_t)cur.am * tstepA + cur.kofs; const char* cB = (const char*)g.Bt + (size_t)cur.bn * tstepB + cur.kofs;
    if constexpr (SP2) {
    PG8_STAGE(PG8_SB(0, 0), cB, voffB); PG8_STAGE(PG8_SB(0, 1), cB + hstepB, voffB); PG8_STAGE(PG8_SA(0, 0), cA, vA[0]); PG8_STAGE(PG8_SA(0, 1), cA + hstepA, vA[1]);
    if (wr == 1) PG8_BAR;
    PG8_WAIT_V(2); PG8_BAR;
    PG8_STAGE(PG8_SB(1, 0), cB + kstep, voffB); PG8_STAGE(PG8_SA(1, 0), cA + kstep, vA[0]); PG8_STAGE(PG8_SB(1, 1), cB + hstepB + kstep, voffB);
    PG8_WAIT_V(6); PG8_BAR;
    } else {
    PG8_STAGE(PG8_SB(0, 0), cB, voffB); PG8_STAGE(PG8_SA(0, 0), cA, vA[0]); PG8_STAGE(PG8_SB(0, 1), cB + hstepB, voffB); PG8_STAGE(PG8_SA(0, 1), cA + hstepA, vA[1]);
    if (wr == 1) PG8_BAR;
    PG8_WAIT_V(4); PG8_BAR;
    PG8_STAGE(PG8_SB(1, 0), cB + kstep, voffB); PG8_STAGE(PG8_SA(1, 0), cA + kstep, vA[0]); PG8_STAGE(PG8_SB(1, 1), cB + hstepB + kstep, voffB);
    PG8_WAIT_V(6); PG8_BAR;
    }
    for (;;) {
        const bool has_next = S.next(ui + 1, nxt);
        if constexpr (AGATHER) { const int un = has_next ? ui + 1 : ui;
#pragma unroll
            for (int h = 0; h < 2; ++h)
#pragma unroll
                for (int i = 0; i < 2; ++i) vN[h][i] = (unsigned)(idxl[un * 256 + h * 128 + gR[i]] * g.lda + gC[i]); }
        const char* nA = has_next ? (const char*)g.A + (size_t)nxt.am * tstepA + nxt.kofs : cA; const char* nB = has_next ? (const char*)g.Bt + (size_t)nxt.bn * tstepB + nxt.kofs : cB;
        for (int t = 0; t < nt; t += 2) {
            const bool last = (t == nt - 2);
            const char* a1 = cA + (size_t)(t + 1) * kstep;
            const char* a2 = last ? nA : cA + (size_t)(t + 2) * kstep; const char* b2 = last ? nB : cB + (size_t)(t + 2) * kstep;
            const char* a3 = a2 + kstep; const char* b3 = b2 + kstep;
            unsigned w0[2], w1[2];
#pragma unroll
            for (int i = 0; i < 2; ++i) { w0[i] = last ? vN[0][i] : vA[0][i]; w1[i] = last ? vN[1][i] : vA[1][i]; }
            if constexpr (SP2) {
            const int fz = __builtin_amdgcn_readfirstlane(((t == 0) && (ui > 0)) ? 1 : 0);
            PG8_LDB(B0, 0, 0); PG8_LDB(B1, 0, 1); PG8_SCHED; PG8_LDA(At, 0, 0); PG8_STAGE(PG8_SA(1, 1), a1 + hstepA, vA[1]);
            PG8_WAIT_V8E(); PG8_WAIT_L(0); PG8_BAR; PG8_MMA(0, 0, At, B0); PG8_MMA(0, 1, At, B1); PG8_BAR; PG8_SCHED;
            PG8_LDA(At, 0, 1); PG8_STAGE(PG8_SB(0, 0), b2, voffB); PG8_STAGE(PG8_SB(0, 1), b2 + hstepB, voffB); PG8_STAGE(PG8_SA(0, 0), a2, w0);
            PG8_WAIT_V8E(); PG8_WAIT_L(0); PG8_BAR; PG8_MMA(1, 0, At, B0); PG8_MMA(1, 1, At, B1); PG8_BAR; PG8_SCHED;
            PG8_LDB(B0, 1, 0); PG8_LDB(B1, 1, 1); PG8_SCHED; PG8_LDA(At, 1, 0); PG8_STAGE(PG8_SA(0, 1), a2 + hstepA, w1);
            PG8_WAIT_V(8); PG8_WAIT_L(0); PG8_BAR; PG8_MMA(0, 0, At, B0); PG8_MMA(0, 1, At, B1); PG8_BAR; PG8_SCHED;
            PG8_LDA(At, 1, 1); PG8_STAGE(PG8_SB(1, 0), b3, voffB); PG8_STAGE(PG8_SB(1, 1), b3 + hstepB, voffB); PG8_STAGE(PG8_SA(1, 0), a3, w0);
            PG8_WAIT_V(8); PG8_WAIT_L(0); PG8_BAR; PG8_MMA(1, 0, At, B0); PG8_MMA(1, 1, At, B1); PG8_BAR; PG8_SCHED;
            } else {
            PG8_LDB(B0, 0, 0); PG8_SCHED; PG8_LDA(At, 0, 0); PG8_STAGE(PG8_SA(1, 1), a1 + hstepA, vA[1]);
            PG8_WAIT_L(8); PG8_BAR; PG8_WAIT_L(0); PG8_MMA(0, 0, At, B0); PG8_BAR; PG8_SCHED;
            PG8_LDB(B1, 0, 1); PG8_STAGE(PG8_SB(0, 0), b2, voffB);
            PG8_BAR; PG8_WAIT_L(0); PG8_MMA(0, 1, At, B1); PG8_BAR;
            PG8_LDA(At, 0, 1); PG8_STAGE(PG8_SA(0, 0), a2, w0);
            PG8_BAR; PG8_WAIT_L(0); PG8_MMA(1, 0, At, B0); PG8_BAR; PG8_SCHED;
            PG8_STAGE(PG8_SB(0, 1), b2 + hstepB, voffB);
            PG8_WAIT_V(6); PG8_BAR; PG8_MMA(1, 1, At, B1); PG8_BAR;
            PG8_LDB(B0, 1, 0); PG8_SCHED; PG8_LDA(At, 1, 0); PG8_STAGE(PG8_SA(0, 1), a2 + hstepA, w1);
            PG8_WAIT_L(8); PG8_BAR; PG8_WAIT_L(0); PG8_MMA(0, 0, At, B0); PG8_BAR; PG8_SCHED;
            PG8_LDB(B1, 1, 1); PG8_STAGE(PG8_SB(1, 0), b3, voffB);
            PG8_BAR; PG8_WAIT_L(0); PG8_MMA(0, 1, At, B1); PG8_BAR;
            PG8_LDA(At, 1, 1); PG8_STAGE(PG8_SA(1, 0), a3, w0);
            PG8_BAR; PG8_WAIT_L(0); PG8_MMA(1, 0, At, B0); PG8_BAR; PG8_SCHED;
            PG8_STAGE(PG8_SB(1, 1), b3 + hstepB, voffB);
            PG8_WAIT_V(6); PG8_BAR; PG8_MMA(1, 1, At, B1); PG8_BAR;
            }
        }
        if constexpr (ALIGN_EPI) { if (wr == 0) PG8_BAR; }
        if constexpr (FP8) asm volatile("s_nop 15\n\ts_nop 15" ::: "memory");
        else asm volatile("s_nop 15" ::: "memory");
        E(acc, cur, wr, wc, fr, fq);
        if (!has_next) break;
#pragma unroll
        for (int a = 0; a < 2; ++a)
#pragma unroll
            for (int b = 0; b < 2; ++b)
#pragma unroll
                for (int m = 0; m < 4; ++m)
#pragma unroll
                    for (int n = 0; n < 2; ++n) acc[a][b][m][n] = (f32x4){0.f, 0.f, 0.f, 0.f};
        cur = nxt; cA = nA; cB = nB; ++ui;
#pragma unroll
        for (int h = 0; h < 2; ++h)
#pragma unroll
            for (int i = 0; i < 2; ++i) vA[h][i] = vN[h][i];
        if constexpr (ALIGN_EPI) { if (wr == 1) PG8_BAR; }
    }
    PG8_WAIT_V(0);
    if constexpr (!ALIGN_EPI) { if (wr == 0) PG8_BAR; }
    PG8_BAR;
#undef PG8_SA
#undef PG8_SB
#undef PG8_STAGE
#undef PG8_LDA
#undef PG8_LDB
#undef PG8_MMA
#undef PG8_CAT
#undef PG8_WAIT_V
#undef PG8_WAIT_V8E
#undef PG8_W8E_ASM
#undef PG8_WAIT_L
#undef PG8_BAR
#undef PG8_SCHED
}

struct RectSched {
    int nM, nN, nwg, G, c, nextra, extra_pm0, extra_pn0, extra_nn;
    int pn_split, pn_shift;
    int skew_full, skew_c0;
    __device__ void init(int nM_, int nN_, int G_, int c_) { nM = nM_; nN = nN_; nwg = nM * nN; G = G_; c = c_; nextra = 0; extra_pm0 = extra_pn0 = 0; extra_nn = 1; pn_split = 1 << 20; pn_shift = 0; skew_full = 1 << 20; skew_c0 = 0; }
    __device__ bool next(int i, Unit& u) const {
        long L;
        if (i < skew_full) L = (long)i * G + c; else { if (c < skew_c0) return false; L = (long)skew_full * G + (long)(i - skew_full) * (G - skew_c0) + (c - skew_c0); }
        if (L >= nwg + nextra) return false;
        if (L >= nwg) { const int j = (int)L - nwg; u.pm = extra_pm0 + j / extra_nn; u.pn = extra_pn0 + j % extra_nn; u.am = u.pm; u.bn = u.pn; u.kofs = 0; return true; }
        int wgid = (int)L; { const int q = nwg / 8, r = nwg % 8, xcd = wgid % 8, off = wgid / 8; wgid = (xcd < r ? xcd * (q + 1) : r * (q + 1) + (xcd - r) * q) + off; }
        const int nig = 8 * nN, gid = wgid / nig, fm = gid * 8, gsz = (nM - fm) < 8 ? (nM - fm) : 8;
        u.pm = fm + ((wgid % nig) % gsz); u.pn = (wgid % nig) / gsz; if (u.pn >= pn_split) u.pn += pn_shift; u.am = u.pm; u.bn = u.pn; u.kofs = 0; return true;
    }
};
struct ExpertSched {
    int pe, te, G, c;
    __device__ bool next(int i, Unit& u) const {
        const int cv = (G & 7) == 0 ? (c & 7) * (G >> 3) + (c >> 3) : c;
        const long L = (long)i * G + cv; const int per = pe * te; if (L >= (long)NE * per) return false;
        const int e = (int)L / per, r = (int)L % per, pn_l = r / pe, pm_l = r % pe;
        u.pm = e * PPE + pm_l; u.pn = e * te + pn_l; u.am = u.pm; u.bn = u.pn; u.kofs = 0; return true;
    }
};
struct BranchSched {
    int nM, G, c;
    __device__ bool next(int it, Unit& u) const {
        const int cv = (G & 7) == 0 ? (c & 7) * (G >> 3) + (c >> 3) : c;
        const long L = (long)it * G + cv; if (L >= (long)nM * 32) return false;
        const int blk = (int)L >> 5, w = (int)L & 31, ng = nM >> 3;
        const int i = blk / (2 * ng), pm = ((blk >> 1) % ng) * 8 + (w & 7), pn = (blk & 1) * 4 + (w >> 3);
        u.pm = pm; u.pn = i * 8 + pn; u.am = pm; u.bn = pn; u.kofs = i * 512 * 2; return true;
    }
};
struct TSched {
    int G, c;
    __device__ bool next(int it, Unit& u) const {
        const long L = (long)it * G + c; if (L >= NB * 16 * 4) return false;
        const int pn = (int)L & 3, bg = (int)L >> 2, b = bg >> 4, gq = bg & 15;
        u.pm = bg; u.pn = pn; u.am = b * 1024 + gq; u.bn = 14 + pn; u.kofs = 0; return true;
    }
};
struct FourierCtxSched {
    int G, c;
    __device__ bool next(int i, Unit& u) const {
        const long L = (long)i * G + (c + G - G / 2) % G; if (L >= 16) return false;
        const int b = (int)L >> 1, pn = (int)L & 1;
        u.pm = ML / 256 + b; u.pn = pn; u.am = 0; u.bn = b * 2 + pn; u.kofs = 0; return true;
    }
};
}
using pg8::Unit;

#define EPI_LOOP_AM _Pragma("unroll") for (int ai = 0; ai < 2; ++ai) _Pragma("unroll") for (int m = 0; m < 4; ++m)
__device__ __forceinline__ u32x4 pack8(const f32x4& v0, const f32x4& v1) { u32x4 w; w.x = cvt_pk(v0[0], v0[1]); w.y = cvt_pk(v0[2], v0[3]); w.z = cvt_pk(v1[0], v1[1]); w.w = cvt_pk(v1[2], v1[3]); return w; }

struct EpiWin {
    static constexpr bool PERM = true, SEG = false; static constexpr int NSTH = 4;
    bf16 *P, *GB, *Q, *KB, *ZP, *VT, *VTC, *TT, *TTC; const float *qnw, *knw;
    __device__ __forceinline__ void operator()(const f32x4 (&acc)[2][2][4][2], const Unit& u, int wr, int wc, int fr, int fq) const {
        const int pn = u.pn; const int rowb = u.pm * 256 + wr * 64 + fr; const int cl8 = wc * 32 + 8 * fq;
        const bool isctx = u.pm >= ML / 256;
        if (pn < 4) {
            EPI_LOOP_AM { const size_t row = rowb + ai * 128 + m * 16; const f32x4 v0 = acc[ai][0][m][0] * acc[ai][1][m][0], v1 = acc[ai][0][m][1] * acc[ai][1][m][1];
                *(u32x4*)(P + row * 512 + 128 * pn + cl8) = pack8(v0, v1); }
        } else if (pn < 6 || pn == 12 || pn == 13) {
            bf16* O = pn < 6 ? GB : ZP; const int c0 = 256 * (pn < 6 ? pn - 4 : pn - 12) + cl8;
            EPI_LOOP_AM { const size_t row = rowb + ai * 128 + m * 16;
#pragma unroll
                for (int bj = 0; bj < 2; ++bj) *(u32x4*)(O + row * 512 + c0 + 128 * bj) = pack8(acc[ai][bj][m][0], acc[ai][bj][m][1]); }
        } else if (pn < 10) {
            const bool isq = pn < 8; const float* nw = isq ? qnw : knw; bf16* O = isq ? Q : KB; const int head = 4 * (pn & 1) + wc; const float osc = isq ? 0.125f * LOG2E : 1.0f;
            f32x4 w[2][2];
#pragma unroll
            for (int bj = 0; bj < 2; ++bj)
#pragma unroll
                for (int n = 0; n < 2; ++n) w[bj][n] = *(const f32x4*)(nw + 32 * bj + 8 * fq + 4 * n) * osc;
            EPI_LOOP_AM { const size_t row = rowb + ai * 128 + m * 16; float ss = 0.f;
#pragma unroll
                for (int bj = 0; bj < 2; ++bj)
#pragma unroll
                    for (int n = 0; n < 2; ++n) { const f32x4 x = acc[ai][bj][m][n]; ss += (x[0] * x[0] + x[1] * x[1]) + (x[2] * x[2] + x[3] * x[3]); }
                ss += shx(ss, 16); ss += shx(ss, 32);
                const float rs = __builtin_amdgcn_rsqf(ss * (1.0f / 64.0f) + EPS);
#pragma unroll
                for (int bj = 0; bj < 2; ++bj) *(u32x4*)(O + row * 512 + 64 * head + 32 * bj + 8 * fq) = pack8(acc[ai][bj][m][0] * rs * w[bj][0], acc[ai][bj][m][1] * rs * w[bj][1]); }
        } else if (pn < 12) {
            const int head = 4 * (pn & 1) + wc; const int b = isctx ? (u.pm - ML / 256) : (u.pm >> 4);
            bf16* O = isctx ? VTC + (size_t)(b * NH + head) * HD * LC : VT + (size_t)(b * NH + head) * HD * SEQ; const int npitch = isctx ? LC : SEQ;
            const int tokb = isctx ? (wr * 64 + fr) : ((u.pm & 15) * 256 + wr * 64 + fr);
            EPI_LOOP_AM { const int tok = tokb + ai * 128 + m * 16;
#pragma unroll
                for (int bj = 0; bj < 2; ++bj)
#pragma unroll
                    for (int n = 0; n < 2; ++n)
#pragma unroll
                        for (int j = 0; j < 4; ++j) O[(size_t)(32 * bj + 8 * fq + 4 * n + j) * npitch + tok] = f2bf(acc[ai][bj][m][n][j]); }
        } else if (pn < 18) {
            const int b = isctx ? (u.pm - ML / 256) : (u.pm >> 4); const int npitch = isctx ? LC : SEQ;
            bf16* O = isctx ? TTC + (size_t)b * 512 * 2 * LC : TT + (size_t)b * 512 * 2 * SEQ;
            const int tokb = isctx ? (wr * 64 + fr) : ((u.pm & 15) * 256 + wr * 64 + fr);
            EPI_LOOP_AM { const int tok = tokb + ai * 128 + m * 16;
#pragma unroll
                for (int bj = 0; bj < 2; ++bj)
#pragma unroll
                    for (int n = 0; n < 2; ++n)
#pragma unroll
                        for (int j = 0; j < 4; ++j) { const int uu = 256 * (pn - 14) + 128 * bj + cl8 + 4 * n + j; const int part = uu >> 9, cp = uu & 511;
                            O[((size_t)cp * 2 + part) * npitch + tok] = f2bf(acc[ai][bj][m][n][j]); } }
        }
    }
};
struct EpiQKV8 {
    static constexpr bool PERM = true, SEG = false; static constexpr int NSTH = 8;
    bf16 *Q, *KB, *VT, *VTC; const float *qnw, *knw; LAS unsigned char* xl;
    __device__ __forceinline__ void operator()(const f32x4 (&acc)[2][2][4][2], const Unit& u, int wr, int wc, int fr, int fq) const {
        const int pn = u.pn + 6; const int rowb = u.pm * 256 + wr * 64 + fr; const bool isctx = u.pm >= ML / 256; constexpr float is = 1.0f / W8SCALE;
        if (pn < 10) {
            const bool isq = pn < 8; const float* nw = isq ? qnw : knw; bf16* O = isq ? Q : KB; const int head = 4 * (pn & 1) + wc; const float osc = isq ? 0.125f * LOG2E : 1.0f;
            f32x4 w[2][2];
#pragma unroll
            for (int bj = 0; bj < 2; ++bj)
#pragma unroll
                for (int n = 0; n < 2; ++n) w[bj][n] = *(const f32x4*)(nw + 32 * bj + 8 * fq + 4 * n) * (osc * is);
            EPI_LOOP_AM { const size_t row = rowb + ai * 128 + m * 16; float ss = 0.f;
#pragma unroll
                for (int bj = 0; bj < 2; ++bj)
#pragma unroll
                    for (int n = 0; n < 2; ++n) { const f32x4 x = acc[ai][bj][m][n] * is; ss += (x[0] * x[0] + x[1] * x[1]) + (x[2] * x[2] + x[3] * x[3]); }
                ss += shx(ss, 16); ss += shx(ss, 32);
                const float rs = __builtin_amdgcn_rsqf(ss * (1.0f / 64.0f) + EPS);
#pragma unroll
                for (int bj = 0; bj < 2; ++bj) *(u32x4*)(O + row * 512 + 64 * head + 32 * bj + 8 * fq) = pack8(acc[ai][bj][m][0] * rs * w[bj][0], acc[ai][bj][m][1] * rs * w[bj][1]); }
        } else {
            const int head = 4 * (pn & 1) + wc; const int b = isctx ? (u.pm - ML / 256) : (u.pm >> 4);
            bf16* O = isctx ? VTC + (size_t)(b * NH + head) * HD * LC : VT + (size_t)(b * NH + head) * HD * SEQ; const int npitch = isctx ? LC : SEQ;
            const int tok0 = isctx ? (wr * 64) : ((u.pm & 15) * 256 + wr * 64); const int ln = fr + 16 * fq, dr = ln & 31, hf = ln >> 5;
            LAS unsigned char* xw = xl + (wr * 4 + wc) * 2304;
            EPI_LOOP_AM {
#pragma unroll
                for (int bj = 0; bj < 2; ++bj) {
#pragma unroll
                    for (int n = 0; n < 2; ++n)
#pragma unroll
                        for (int j = 0; j < 4; ++j) { const int dl = 8 * fq + 4 * n + j; *(LAS bf16*)(xw + 32 * (dl + fq) + 2 * fr) = f2bf(acc[ai][bj][m][n][j] * is); }
                    asm volatile("" ::: "memory");
                    const u32x4 r = *(const LAS u32x4*)(xw + 32 * (dr + (dr >> 3)) + 16 * hf);
                    asm volatile("" ::: "memory");
                    *(u32x4*)(O + (size_t)(32 * bj + dr) * npitch + tok0 + ai * 128 + m * 16 + 8 * hf) = r; } }
        }
    }
};
struct EpiWinT {
    static constexpr bool PERM = true, SEG = false; static constexpr int NSTH = 8;
    bf16* TT; LAS unsigned char* xl;
    __device__ __forceinline__ void operator()(const f32x4 (&acc)[2][2][4][2], const Unit& u, int wr, int wc, int fr, int fq) const {
        const int b = u.pm >> 4, gq = u.pm & 15; bf16* O = TT + (size_t)b * 512 * 2 * SEQ;
        LAS unsigned char* xw = xl + (wr * 4 + wc) * 2304;
        const int ln = fr + 16 * fq, fqr = ln >> 4, jr = (ln >> 2) & 3, n2r = ln & 3;
#pragma unroll
        for (int ai = 0; ai < 2; ++ai)
#pragma unroll
            for (int bj = 0; bj < 2; ++bj)
#pragma unroll
                for (int n = 0; n < 2; ++n) {
#pragma unroll
                    for (int m = 0; m < 4; ++m)
#pragma unroll
                        for (int j = 0; j < 4; ++j) *(LAS bf16*)(xw + 32 * (16 * fq + 4 * j + (fr & 3)) + 8 * fq + 2 * (4 * m + (fr >> 2))) = f2bf(acc[ai][bj][m][n][j]);
                    asm volatile("" ::: "memory");
                    const LAS unsigned char* rp = xw + 32 * ln + 8 * fqr;
                    const u32x2 r0 = *(const LAS u32x2*)(rp), r1 = *(const LAS u32x2*)(rp + 8), r2 = *(const LAS u32x2*)(rp + 16), r3 = *(const LAS u32x2*)(rp + 24);
                    asm volatile("" ::: "memory");
                    const int uu = 256 * u.pn + 128 * bj + 32 * wc + 8 * fqr + 4 * n + jr; const int part = uu >> 9, cp = uu & 511;
                    bf16* op = O + (((size_t)cp * 64 + 4 * gq + n2r) * 2 + part) * 64 + 32 * ai + 16 * wr;
                    u32x4 w0, w1; w0.x = r0.x; w0.y = r0.y; w0.z = r1.x; w0.w = r1.y; w1.x = r2.x; w1.y = r2.y; w1.z = r3.x; w1.w = r3.y;
                    *(u32x4*)op = w0; *(u32x4*)(op + 8) = w1; }
    }
};
struct EpiPlain {
    static constexpr bool PERM = true, SEG = false; static constexpr int NSTH = 8;
    bf16* O; int ldc; int col0;
    __device__ __forceinline__ void operator()(const f32x4 (&acc)[2][2][4][2], const Unit& u, int wr, int wc, int fr, int fq) const {
        const int rowb = u.pm * 256 + wr * 64 + fr; const int c0 = col0 + 256 * u.pn + wc * 32 + 8 * fq;
        EPI_LOOP_AM { const size_t row = rowb + ai * 128 + m * 16;
#pragma unroll
            for (int bj = 0; bj < 2; ++bj) *(u32x4*)(O + row * ldc + c0 + 128 * bj) = pack8(acc[ai][bj][m][0], acc[ai][bj][m][1]); }
    }
};
struct EpiY {
    static constexpr bool PERM = true, SEG = false; static constexpr int NSTH = 8;
    bf16* O;
    __device__ __forceinline__ void operator()(const f32x4 (&acc)[2][2][4][2], const Unit& u, int wr, int wc, int fr, int fq) const {
        const int rowb = u.pm * 256 + wr * 64 + fr; const int c0 = 256 * (u.pn & 7) + wc * 32 + 8 * fq;
        EPI_LOOP_AM { const size_t row = rowb + ai * 128 + m * 16;
#pragma unroll
            for (int bj = 0; bj < 2; ++bj) *(u32x4*)(O + row * D + c0 + 128 * bj) = pack8(acc[ai][bj][m][0] * (1.0f / W8SCALE), acc[ai][bj][m][1] * (1.0f / W8SCALE)); }
    }
};
struct EpiGate {
    static constexpr bool PERM = true, SEG = false; static constexpr int NSTH = 2;
    const bf16* PB; bf16* MG;
    __device__ __forceinline__ void operator()(const f32x4 (&acc)[2][2][4][2], const Unit& u, int wr, int wc, int fr, int fq) const {
        const int rowb = u.pm * 256 + wr * 64 + fr; const int odd = fq & 1; const int colp = 64 * u.pn + 16 * wc + 4 * (fq & 2);
#pragma unroll
        for (int ai = 0; ai < 2; ++ai) {
            u32x4 tq[4][2];
#pragma unroll
            for (int m = 0; m < 4; ++m)
#pragma unroll
                for (int pp = 0; pp < 2; ++pp) tq[m][pp] = *(const u32x4*)(PB + (size_t)(rowb + ai * 128 + m * 16) * 8192 + colp + odd * 2048 + pp * 4096);
            asm volatile("" ::: "memory");
#pragma unroll
            for (int mp = 0; mp < 2; ++mp) {
                u32x2 wv[2];
#pragma unroll
                for (int mm = 0; mm < 2; ++mm) { const int m = 2 * mp + mm;
                    u32x2 pv[4];
#pragma unroll
                    for (int pp = 0; pp < 2; ++pp) { const u32x4 t = tq[m][pp];
                        const auto s0 = __builtin_amdgcn_permlane16_swap(t.x, t.z, false, false), s1 = __builtin_amdgcn_permlane16_swap(t.y, t.w, false, false);
                        pv[2 * pp].x = s0[0]; pv[2 * pp].y = s1[0]; pv[2 * pp + 1].x = s0[1]; pv[2 * pp + 1].y = s1[1]; }
                    f32x4 o = (f32x4){0.f, 0.f, 0.f, 0.f};
#pragma unroll
                    for (int bj = 0; bj < 2; ++bj)
#pragma unroll
                        for (int n = 0; n < 2; ++n) { const u32x2 pq = pv[2 * bj + n]; const f32x4 g = acc[ai][bj][m][n] * (1.0f / W8SCALE);
                            o[0] += sigmoidf_(g[0]) * bflo(pq.x); o[1] += sigmoidf_(g[1]) * bfhi(pq.x); o[2] += sigmoidf_(g[2]) * bflo(pq.y); o[3] += sigmoidf_(g[3]) * bfhi(pq.y); }
                    wv[mm].x = cvt_pk(o[0], o[1]); wv[mm].y = cvt_pk(o[2], o[3]); }
                const auto s0 = __builtin_amdgcn_permlane16_swap(wv[0].x, wv[1].x, false, false), s1 = __builtin_amdgcn_permlane16_swap(wv[0].y, wv[1].y, false, false);
                u32x4 w; w.x = s0[0]; w.y = s1[0]; w.z = s0[1]; w.w = s1[1];
                *(u32x4*)(MG + (size_t)(rowb + ai * 128 + (2 * mp + odd) * 16) * D + colp) = w; }
        }
    }
};
struct EpiWout {
    static constexpr bool PERM = false, SEG = false; static constexpr int NSTH = 16;
    const float *xin_l, *xin_c; float *xout_l, *xout_c; const float* modl; const float* bada;
    __device__ __forceinline__ void operator()(const f32x4 (&acc)[2][2][4][2], const Unit& u, int wr, int wc, int fr, int fq) const {
        const bool isctx = u.pm >= ML / 256; const int s = isctx ? 8 : (u.pm >> 4);
        const float* xi = isctx ? xin_c - (size_t)ML * D : xin_l; float* xo = isctx ? xout_c - (size_t)ML * D : xout_l;
        const int rowb = u.pm * 256 + wr * 64 + fr; const int c0 = 256 * u.pn + wc * 32 + 4 * fq;
        f32x4 gv[2][2];
#pragma unroll
        for (int bj = 0; bj < 2; ++bj)
#pragma unroll
            for (int n = 0; n < 2; ++n) { const int c = c0 + 128 * bj + 16 * n; gv[bj][n] = *(const f32x4*)(modl + (size_t)s * 6 * D + 2 * D + c) + *(const f32x4*)(bada + 2 * D + c); }
#pragma unroll
        for (int ai = 0; ai < 2; ++ai) {
            f32x4 xr[4][2][2];
#pragma unroll
            for (int m = 0; m < 4; ++m)
#pragma unroll
                for (int bj = 0; bj < 2; ++bj)
#pragma unroll
                    for (int n = 0; n < 2; ++n) xr[m][bj][n] = *(const f32x4*)(xi + (size_t)(rowb + ai * 128 + m * 16) * D + c0 + 128 * bj + 16 * n);
            asm volatile("" ::: "memory");
#pragma unroll
            for (int m = 0; m < 4; ++m)
#pragma unroll
                for (int bj = 0; bj < 2; ++bj)
#pragma unroll
                    for (int n = 0; n < 2; ++n) *(f32x4*)(xo + (size_t)(rowb + ai * 128 + m * 16) * D + c0 + 128 * bj + 16 * n) = xr[m][bj][n] + gv[bj][n] * acc[ai][bj][m][n];
            asm volatile("" ::: "memory");
        }
    }
};
struct EpiGU {
    static constexpr bool PERM = true, SEG = false; static constexpr int NSTH = 4;
    unsigned char* HID;
    __device__ __forceinline__ void operator()(const f32x4 (&acc)[2][2][4][2], const Unit& u, int wr, int wc, int fr, int fq) const {
        const int rowb = u.pm * 256 + wr * 64 + fr; const int c0 = 128 * (u.pn & 15) + wc * 32 + 8 * fq;
        constexpr float is = 1.0f / W8SCALE;
        EPI_LOOP_AM { const size_t row = rowb + ai * 128 + m * 16; f32x4 v0, v1;
#pragma unroll
            for (int j = 0; j < 4; ++j) { v0[j] = siluf_(acc[ai][0][m][0][j] * is) * (acc[ai][1][m][0][j] * is); v1[j] = siluf_(acc[ai][0][m][1][j] * is) * (acc[ai][1][m][1][j] * is); }
            u32x2 w; w.x = cvt4_fp8(v0[0], v0[1], v0[2], v0[3]); w.y = cvt4_fp8(v1[0], v1[1], v1[2], v1[3]);
            *(u32x2*)(HID + row * FF + c0) = w; }
    }
};

struct Args {
    const float *x, *c, *ctx, *c_ctx, *w_ada, *b_ada, *norm1_w, *norm2_w, *w_in, *conv_w, *q_norm_w, *k_norm_w, *na_rpb, *pool_w, *pool_scale, *w_branch, *w_out, *w_router, *w_exp_gate, *w_exp_up, *w_exp_down;
    float* out; unsigned char* ws; int ph_lo, ph_hi;
};
struct Frame { LAS unsigned char* lds; int tid, lane, wave, G, c; };
#define GPTR(T, v) ((T*)(__attribute__((address_space(1))) T*)(v))
__device__ __forceinline__ Args load_args() {
    typedef const unsigned long long __attribute__((address_space(4))) * KW;
    KW p = (KW)__builtin_amdgcn_kernarg_segment_ptr(); asm volatile("" : "+s"(p));
    Args r;
    r.x = GPTR(const float, p[0]);
    r.c = GPTR(const float, p[1]);
    r.ctx = GPTR(const float, p[2]);
    r.c_ctx = GPTR(const float, p[3]);
    r.w_ada = GPTR(const float, p[4]);
    r.b_ada = GPTR(const float, p[5]);
    r.norm1_w = GPTR(const float, p[6]);
    r.norm2_w = GPTR(const float, p[7]);
    r.w_in = GPTR(const float, p[8]);
    r.conv_w = GPTR(const float, p[9]);
    r.q_norm_w = GPTR(const float, p[10]);
    r.k_norm_w = GPTR(const float, p[11]);
    r.na_rpb = GPTR(const float, p[12]);
    r.pool_w = GPTR(const float, p[13]);
    r.pool_scale = GPTR(const float, p[14]);
    r.w_branch = GPTR(const float, p[15]);
    r.w_out = GPTR(const float, p[16]);
    r.w_router = GPTR(const float, p[17]);
    r.w_exp_gate = GPTR(const float, p[18]);
    r.w_exp_up = GPTR(const float, p[19]);
    r.w_exp_down = GPTR(const float, p[20]);
    r.out = GPTR(float, p[21]); r.ws = GPTR(unsigned char, p[22]); r.ph_lo = 0; r.ph_hi = 0;
    return r;
}
#define ARGS_HERE const Args a = load_args()
__device__ __forceinline__ Frame fresh_frame(LAS unsigned char* lds, int wave) {
    Frame F; const int t = fresh_tid(wave); F.lds = lds; F.tid = t; F.lane = t & 63; F.wave = wave; F.G = gridDim.x; F.c = blockIdx.x; return F; }

__device__ __forceinline__ void tr_item_bf16(const float* srcq, size_t ldsrc, bf16* dst, size_t lddst, int g) {
    f32x4 v[8];
#pragma unroll
    for (int i = 0; i < 8; ++i) v[i] = __builtin_nontemporal_load((const f32x4*)(srcq + (size_t)(8 * g + i) * ldsrc));
#pragma unroll
    for (int e = 0; e < 4; ++e) { u32x4 o; o.x = cvt_pk(v[0][e], v[1][e]); o.y = cvt_pk(v[2][e], v[3][e]); o.z = cvt_pk(v[4][e], v[5][e]); o.w = cvt_pk(v[6][e], v[7][e]);
        *(u32x4*)(dst + (size_t)e * lddst + 8 * g) = o; }
}
__device__ __forceinline__ void tr_load_fp8(const float* srcq, size_t ldsrc, int g, f32x4 (&v)[16]) {
#pragma unroll
    for (int i = 0; i < 16; ++i) v[i] = __builtin_nontemporal_load((const f32x4*)(srcq + (size_t)(16 * g + i) * ldsrc));
}
__device__ __forceinline__ void tr_store_fp8(const f32x4 (&v)[16], unsigned char* dst, size_t lddst, int g) {
#pragma unroll
    for (int e = 0; e < 4; ++e) { u32x4 o;
        o.x = cvt4_fp8(v[0][e] * W8SCALE, v[1][e] * W8SCALE, v[2][e] * W8SCALE, v[3][e] * W8SCALE); o.y = cvt4_fp8(v[4][e] * W8SCALE, v[5][e] * W8SCALE, v[6][e] * W8SCALE, v[7][e] * W8SCALE);
        o.z = cvt4_fp8(v[8][e] * W8SCALE, v[9][e] * W8SCALE, v[10][e] * W8SCALE, v[11][e] * W8SCALE); o.w = cvt4_fp8(v[12][e] * W8SCALE, v[13][e] * W8SCALE, v[14][e] * W8SCALE, v[15][e] * W8SCALE);
        __builtin_nontemporal_store(o, (u32x4*)(dst + (size_t)e * lddst + 16 * g)); }
}
__device__ __forceinline__ void tr_item_fp8(const float* srcq, size_t ldsrc, unsigned char* dst, size_t lddst, int g) { f32x4 v[16]; tr_load_fp8(srcq, ldsrc, g, v); tr_store_fp8(v, dst, lddst, g); }
__device__ __forceinline__ int win_src_col(int Gd, int q) {
    const int pn = Gd >> 3, g8 = Gd & 7, bj = g8 >> 2, wc = g8 & 3;
    if (pn < 4) return (bj ? 1024 : 0) + 128 * pn + 32 * wc + 4 * q;
    if (pn < 6) return 512 + 256 * (pn - 4) + 32 * g8 + 4 * q;
    if (pn < 12) return 1536 + 512 * ((pn - 6) >> 1) + 64 * (4 * (pn & 1) + wc) + 32 * bj + 4 * q;
    if (pn < 14) return 3584 + 256 * (pn - 12) + 32 * g8 + 4 * q;
    if (pn < 18) return -1;
    return 4096 + (2 * bj + (q & 1)) * 2048 + 64 * (pn - 18) + 16 * wc + 4 * (q >> 1);
}
__device__ __forceinline__ void convert_weights(const Frame& F, const Args& a, int l) {
    unsigned char* ws = a.ws;
    bf16* Win_t = (bf16*)(ws + WS_WIN); bf16* Wbr_t = (bf16*)(ws + WS_WBR); bf16* Wout_t = (bf16*)(ws + WS_WOUT); unsigned char* Wgu_t = ws + WS_WGU; unsigned char* Wd_t = ws + WS_WD;
    const int gw = F.c * 8 + F.wave, NGW = F.G * 8; const int q = F.lane & 7, g = F.lane >> 3;
    const float* w_in = a.w_in + (size_t)l * D * INC; const float* w_br = a.w_branch + (size_t)l * 4 * MIXW * D; const float* w_out = a.w_out + (size_t)l * D * D;
    const float* w_g = a.w_exp_gate + (size_t)l * NE * D * FF; const float* w_u = a.w_exp_up + (size_t)l * NE * D * FF; const float* w_d = a.w_exp_down + (size_t)l * NE * FF * D;
    constexpr int I_WIN = 32 * 400, I_WBR = 3 * 8 * 64, I_WOUT = 32 * 64, I_WGU = NE * 16 * 128, I_WD = NE * 16 * 64;
    {
        constexpr int NT = NE * 3 * 16 * 8;
        const int w = F.wave, ln = F.lane;
        auto src_of = [&](int t) -> const float* { const int em = t >> 7, e = em / 3, m = em - 3 * e, kb = (t >> 3) & 15, nb = t & 7;
            const float* W = m == 0 ? w_g : (m == 1 ? w_u : w_d); return W + (size_t)e * D * FF + (size_t)(128 * kb + 16 * w) * 2048 + 256 * nb + 4 * ln; };
        f32x4 v[16];
        int t = F.c, par = 0;
        __syncthreads();
        if (t < NT) { const float* sp = src_of(t);
#pragma unroll
            for (int i = 0; i < 16; ++i) v[i] = __builtin_nontemporal_load((const f32x4*)(sp + (size_t)i * 2048)); }
#pragma unroll 1
        for (; t < NT; t += F.G) {
            f32x4 vn[16];
            if (t + F.G < NT) { const float* sp = src_of(t + F.G);
#pragma unroll
                for (int i = 0; i < 16; ++i) vn[i] = __builtin_nontemporal_load((const f32x4*)(sp + (size_t)i * 2048)); }
            LAS unsigned char* tb = F.lds + par * 32768;
#pragma unroll
            for (int e = 0; e < 4; ++e) { u32x4 o;
                o.x = cvt4_fp8(v[0][e] * W8SCALE, v[1][e] * W8SCALE, v[2][e] * W8SCALE, v[3][e] * W8SCALE); o.y = cvt4_fp8(v[4][e] * W8SCALE, v[5][e] * W8SCALE, v[6][e] * W8SCALE, v[7][e] * W8SCALE);
                o.z = cvt4_fp8(v[8][e] * W8SCALE, v[9][e] * W8SCALE, v[10][e] * W8SCALE, v[11][e] * W8SCALE); o.w = cvt4_fp8(v[12][e] * W8SCALE, v[13][e] * W8SCALE, v[14][e] * W8SCALE, v[15][e] * W8SCALE);
                *(LAS u32x4*)(tb + (4 * ln + e) * 128 + ((w ^ (ln & 7)) * 16)) = o; }
            __syncthreads();
            { const int em = t >> 7, e_ = em / 3, m = em - 3 * e_, kb = (t >> 3) & 15, nb = t & 7; unsigned char* base = m < 2 ? Wgu_t : Wd_t;
#pragma unroll
              for (int j = 0; j < 4; ++j) { const int n = 32 * w + 8 * j + (ln >> 3), c = ln & 7; const u32x4 o = *(const LAS u32x4*)(tb + n * 128 + ((c ^ ((n >> 2) & 7)) * 16));
                  const int col = 256 * nb + n; const size_t row = m < 2 ? (size_t)e_ * 2 * FF + col + 128 * (col >> 7) + 128 * m : (size_t)e_ * D + col;
                  __builtin_nontemporal_store(o, (u32x4*)(base + row * 2048 + 128 * kb + 16 * c)); } }
            par ^= 1;
#pragma unroll
            for (int i = 0; i < 16; ++i) v[i] = vn[i];
        }
        __syncthreads();
    }
    constexpr int NIT = I_WIN + I_WBR + I_WOUT;
#pragma unroll 1
    for (int it = gw; it < NIT; it += NGW) {
        int r = it;
        if (r < I_WIN) { const int kb = r / 400, Gd = r % 400; const int sc = win_src_col(Gd, q);
            if (sc >= 0 && Gd < 18 * 8 && !(Gd >= 6 * 8 && Gd < 12 * 8)) tr_item_bf16(w_in + (size_t)(64 * kb) * INC + sc, INC, Win_t + (size_t)(32 * Gd + 4 * q) * D + 64 * kb, D, g);
            continue; } r -= I_WIN;
        if (r < I_WBR) { const int i = r / 512, r2 = r % 512, kb = r2 / 64, Gd = r2 % 64; tr_item_bf16(w_br + (size_t)i * MIXW * D + (size_t)(64 * kb) * D + 32 * Gd + 4 * q, D, Wbr_t + (size_t)(32 * Gd + 4 * q) * D + 512 * i + 64 * kb, D, g); continue; } r -= I_WBR;
        { const int kb = r / 64, Gd = r % 64; tr_item_bf16(w_out + (size_t)(64 * kb) * D + 32 * Gd + 4 * q, D, Wout_t + (size_t)(32 * Gd + 4 * q) * D + 64 * kb, D, g); }
    }
#pragma unroll 1
    for (int it = gw; it < 16 * 48; it += NGW) { const int kb = it / 48, Gdp = it % 48; const int sc = win_src_col(Gdp + 6 * 8, q);
        tr_item_fp8(w_in + (size_t)(128 * kb) * INC + sc, INC, ws + WS_WQKV8 + (size_t)(32 * Gdp + 4 * q) * D + 128 * kb, D, g); }
#pragma unroll 1
    for (int it = gw; it < 16 * 256; it += NGW) { const int kb = it >> 8, Gdp = it & 255; const int sc = win_src_col(Gdp + 18 * 8, q);
        tr_item_fp8(w_in + (size_t)(128 * kb) * INC + sc, INC, ws + WS_WG8 + (size_t)(32 * Gdp + 4 * q) * D + 128 * kb, D, g); }
    __syncthreads();
    LAS float* trig = (LAS float*)F.lds;
    LAS float* wl = (LAS float*)(F.lds + 1024);
    if (F.tid < 128) { float sv, cv; sincospif((float)F.tid * (2.0f / 128.0f), &sv, &cv); trig[F.tid] = cv * 0.08838834764831845f; trig[128 + F.tid] = sv * 0.08838834764831845f; }
    const int half = F.tid >> 8, ht = F.tid & 255, part = ht >> 7, c2 = ht & 127;
#pragma unroll 1
    for (int it0 = ((F.c + F.G / 4) % F.G) * 2; it0 < 32 * 4; it0 += F.G * 2) {
        const int it = it0 + half; const int kb64 = it >> 2, gg = it & 3;
#pragma unroll 1
        for (int k8 = 0; k8 < 8; ++k8) { const int kb8 = 8 * kb64 + k8;
            __syncthreads();
            { float t4[4];
#pragma unroll
              for (int u = 0; u < 4; ++u) { const int i = ht + 256 * u; t4[u] = w_in[(size_t)(8 * kb8 + (i >> 7)) * INC + 3072 + 128 * gg + (i & 127)]; }
#pragma unroll
              for (int u = 0; u < 4; ++u) wl[half * 1024 + ht + 256 * u] = t4[u]; }
            __syncthreads();
            float acc[8];
#pragma unroll
            for (int kk = 0; kk < 8; ++kk) acc[kk] = 0.f;
#pragma unroll 4
            for (int cc = 0; cc < 128; ++cc) { const float tv = trig[part * 128 + ((cc * c2) & 127)];
#pragma unroll
                for (int kk = 0; kk < 8; ++kk) acc[kk] += wl[half * 1024 + kk * 128 + cc] * tv; }
            u32x4 o; o.x = cvt_pk(acc[0], acc[1]); o.y = cvt_pk(acc[2], acc[3]); o.z = cvt_pk(acc[4], acc[5]); o.w = cvt_pk(acc[6], acc[7]);
            *(u32x4*)(Win_t + (size_t)(14 * 256 + part * 512 + 128 * gg + c2) * D + 8 * kb8) = o; }
    }
    __syncthreads();
    const float* pw = a.pool_w + (size_t)l * 4 * 128 * 128; const float* ps = a.pool_scale + (size_t)l * MIXW; const float* wb3 = w_br + (size_t)3 * MIXW * D;
#pragma unroll 1
    for (int it = gw; it < 8 * 32 * 8; it += NGW) {
        const int gc8 = (it >> 8) * 8 + (it & 7), nb = (it >> 3) & 31, gg = gc8 >> 4; const int n = 64 * nb + F.lane;
        float acc[8];
#pragma unroll
        for (int i = 0; i < 8; ++i) acc[i] = 0.f;
        const float* pwr = pw + (size_t)(8 * gc8) * 128;
        LAS float* pl = (LAS float*)(F.lds + F.wave * 4096);
        { f32x4 t4[4];
#pragma unroll
          for (int k = 0; k < 4; ++k) t4[k] = *(const f32x4*)(pwr + (k * 64 + F.lane) * 4);
#pragma unroll
          for (int k = 0; k < 4; ++k) *(LAS f32x4*)(pl + (k * 64 + F.lane) * 4) = t4[k]; }
        asm volatile("s_waitcnt lgkmcnt(0)" ::: "memory");
#pragma unroll 1
        for (int d0 = 0; d0 < 128; d0 += 8) { float wv[8];
#pragma unroll
            for (int u8 = 0; u8 < 8; ++u8) wv[u8] = ps[128 * gg + d0 + u8] * wb3[(size_t)(128 * gg + d0 + u8) * D + n];
#pragma unroll
            for (int i = 0; i < 8; ++i) { const f32x4 p0 = *(const LAS f32x4*)(pl + i * 128 + d0), p1 = *(const LAS f32x4*)(pl + i * 128 + d0 + 4);
                acc[i] += p0[0] * wv[0]; acc[i] += p0[1] * wv[1]; acc[i] += p0[2] * wv[2]; acc[i] += p0[3] * wv[3];
                acc[i] += p1[0] * wv[4]; acc[i] += p1[1] * wv[5]; acc[i] += p1[2] * wv[6]; acc[i] += p1[3] * wv[7]; } }
        asm volatile("" ::: "memory");
        u32x4 o; o.x = cvt_pk(acc[0], acc[1]); o.y = cvt_pk(acc[2], acc[3]); o.z = cvt_pk(acc[4], acc[5]); o.w = cvt_pk(acc[6], acc[7]);
        *(u32x4*)(Wbr_t + (size_t)n * D + 1536 + 8 * gc8) = o;
    }
}
__device__ __forceinline__ void prologue_misc(const Frame& F, const Args& a) {
    float* MOD = (float*)(a.ws + WS_MOD);
    LAS float* scs = (LAS float*)F.lds;
    LAS float* part = (LAS float*)(F.lds + 9 * D * 4);
    __syncthreads();
    {
        float cv[36];
#pragma unroll
        for (int u = 0; u < 36; ++u) { const int i = F.tid + 512 * u, s = i >> 11, kk = i & 2047; cv[u] = s < 8 ? a.c[(size_t)s * D + kk] : a.c_ctx[kk]; }
#pragma unroll
        for (int u = 0; u < 36; ++u) scs[F.tid + 512 * u] = siluf_(cv[u]);
    }
    __syncthreads();
    for (int it = F.c; it < 2 * 96; it += F.G) {
        const int l = it / 96, jb = it % 96, col = F.tid & 127, kq = F.tid >> 7;
        const int j = 128 * jb + col; const float* wp = a.w_ada + ((size_t)l * D + 512 * kq) * (6 * D) + j;
        float acc[9];
#pragma unroll
        for (int s = 0; s < 9; ++s) acc[s] = 0.f;
#pragma unroll 4
        for (int kk = 0; kk < 512; ++kk) { const float w = __builtin_nontemporal_load(wp + (size_t)kk * (6 * D));
#pragma unroll
            for (int s = 0; s < 9; ++s) acc[s] += scs[s * D + 512 * kq + kk] * w; }
#pragma unroll
        for (int s = 0; s < 9; ++s) part[(kq * 9 + s) * 128 + col] = acc[s];
        __syncthreads();
        for (int i = F.tid; i < 9 * 128; i += 512) { const int s = i >> 7, cc = i & 127;
            MOD[((size_t)l * 9 + s) * (6 * D) + 128 * jb + cc] = ((part[(0 * 9 + s) * 128 + cc] + part[(1 * 9 + s) * 128 + cc]) + part[(2 * 9 + s) * 128 + cc]) + part[(3 * 9 + s) * 128 + cc]; }
        __syncthreads();
    }
    __syncthreads();
    LAS float* tab = (LAS float*)F.lds;
    for (int i = F.tid; i < 256; i += 512) { float sv, cv; sincospif((float)i * (2.0f / 256.0f), &sv, &cv); tab[2 * i] = cv; tab[2 * i + 1] = sv; }
    __syncthreads();
    bf16* DFTC = (bf16*)(a.ws + WS_DFTC);
    for (int kk = F.c; kk < LC; kk += F.G) { unsigned* row = (unsigned*)(DFTC + (size_t)kk * 2 * LC);
        for (int i = F.tid; i < LC; i += 512) { const int part = i >> 7, n = (i & 127) * 2; const int m0 = (kk * n) & 255, m1 = (kk * (n + 1)) & 255;
            const float v0 = part ? -tab[2 * m0 + 1] : tab[2 * m0], v1 = part ? -tab[2 * m1 + 1] : tab[2 * m1]; row[i] = cvt_pk(v0 * (1.0f / 16.0f), v1 * (1.0f / 16.0f)); } }
    __syncthreads();
}

template <int MODE>
__device__ __forceinline__ void norm_phase(const Frame& F, const Args& a, int l, float* xl, float* xc, const float* xl_in, const float* xc_in) {
    const float* MOD = (const float*)(a.ws + WS_MOD); bf16* H = (bf16*)(a.ws + WS_H);
    const bf16* Y = (const bf16*)(a.ws + WS_Y); const float* GSL = (const float*)(a.ws + WS_GSL); const short* INV = (const short*)(a.ws + WS_INV);
    float* AFF = (float*)(a.ws + WS_AFF);
    constexpr bool combine = (MODE == 2) || (MODE == 3);
    constexpr bool N1 = (MODE == 0 || MODE == 3);
    const int lc = (MODE == 2) ? DEPTH - 1 : l - 1;
    const int nrows = (MODE == 2) ? ML : ((MODE == 1 && l == DEPTH - 1) ? ML : MT);
    LAS float* WR = (LAS float*)F.lds;
    if (MODE == 1) { const float* wr = a.w_router + (size_t)l * D * NE; __syncthreads();
        {
#pragma unroll 1
            for (int it0 = 0; it0 < 16; it0 += 8) { f32x4 t4[8];
#pragma unroll
                for (int u = 0; u < 8; ++u) t4[u] = *(const f32x4*)(wr + 4 * (F.tid + 512 * (it0 + u)));
#pragma unroll
                for (int u = 0; u < 8; ++u) { const int i4 = F.tid + 512 * (it0 + u), k = i4 >> 2, e0 = 4 * (i4 & 3);
                    WR[(e0 + 0) * D + k] = t4[u][0]; WR[(e0 + 1) * D + k] = t4[u][1]; WR[(e0 + 2) * D + k] = t4[u][2]; WR[(e0 + 3) * D + k] = t4[u][3]; } } }
        __syncthreads(); }
    const int gw = F.c * 8 + F.wave, NGW = F.G * 8;
    const int rpw = (nrows + NGW - 1) / NGW; const int m0 = gw * rpw; int m1 = m0 + rpw; m1 = m1 > nrows ? nrows : m1;
    const float* nw = (MODE == 1 ? a.norm2_w : a.norm1_w) + (size_t)(MODE == 2 ? 0 : l) * D; (void)N1;
    const int ko = 4 * F.lane;
    f32x4 vA[8], vB[8], vG[8];
    int scur = -1;
    f32x4 v[8];
    if (m0 < m1) { const float* xin = m0 >= ML ? xc_in + (size_t)(m0 - ML) * D : xl_in + (size_t)m0 * D;
#pragma unroll
        for (int j = 0; j < 8; ++j) v[j] = *(const f32x4*)(xin + 256 * j + ko); }
#pragma unroll 1
    for (int m = m0; m < m1; ++m) {
        const bool isctx = m >= ML; const int s = isctx ? 8 : (m >> 12);
        float* xo = isctx ? xc + (size_t)(m - ML) * D : xl + (size_t)m * D;
        if (s != scur) { scur = s;
            if (MODE != 2) { const int ch = (MODE == 1) ? 3 : 0;
                const float* msh = MOD + ((size_t)l * 9 + s) * (6 * D) + (size_t)ch * D; const float* bsh = a.b_ada + (size_t)l * 6 * D + (size_t)ch * D;
#pragma unroll
                for (int j = 0; j < 8; ++j) { const int k = 256 * j + ko;
                    f32x4 t0 = *(const f32x4*)(msh + k), t1 = *(const f32x4*)(bsh + k), t2 = *(const f32x4*)(nw + k), t3 = *(const f32x4*)(msh + D + k), t4 = *(const f32x4*)(bsh + D + k);
                    asm volatile("" : "+v"(t0), "+v"(t1), "+v"(t2), "+v"(t3), "+v"(t4));
                    vB[j] = t0 + t1; vA[j] = t2 * (1.0f + (t3 + t4)); } }
            if (combine && MODE == 2) { const float* mg = MOD + ((size_t)lc * 9 + s) * (6 * D) + 5 * D; const float* bg = a.b_ada + (size_t)lc * 6 * D + 5 * D;
#pragma unroll
                for (int j = 0; j < 8; ++j) vG[j] = *(const f32x4*)(mg + 256 * j + ko) + *(const f32x4*)(bg + 256 * j + ko); }
        }
        f32x4 vn[8];
        if (MODE != 3 && m + 1 < m1) { const int mn = m + 1; const float* xin = mn >= ML ? xc_in + (size_t)(mn - ML) * D : xl_in + (size_t)mn * D;
#pragma unroll
            for (int j = 0; j < 8; ++j) vn[j] = *(const f32x4*)(xin + 256 * j + ko); }
        if (combine) {
            f32x4 acc[8];
#pragma unroll
            for (int j = 0; j < 8; ++j) acc[j] = (f32x4){0.f, 0.f, 0.f, 0.f};
            const int myinv = F.lane < NE ? (int)INV[(size_t)m * NE + F.lane] : -1;
            unsigned emask = (unsigned)(__ballot(myinv >= 0) & 0xFFFFull);
            while (emask) {
                const int e1 = __builtin_ctz(emask); emask &= emask - 1u; const int sl1 = __builtin_amdgcn_readlane(myinv, e1);
                const bool two = emask != 0u; const int e2 = two ? __builtin_ctz(emask) : e1; if (two) emask &= emask - 1u; const int sl2 = __builtin_amdgcn_readlane(myinv, e2);
                const bf16* y1 = Y + ((size_t)e1 * RPE + sl1) * D; const bf16* y2 = Y + ((size_t)e2 * RPE + sl2) * D;
                u32x2 ya[8], yb[8];
#pragma unroll
                for (int j = 0; j < 8; ++j) { ya[j] = *(const u32x2*)(y1 + 256 * j + ko); yb[j] = *(const u32x2*)(y2 + 256 * j + ko); }
                float g1, g2;
                if constexpr (MODE == 2) {
                    int s1v = sl1, s2v = sl2; asm volatile("" : "+v"(s1v), "+v"(s2v));
                    g1 = GSL[(size_t)e1 * RPE + s1v]; g2 = GSL[(size_t)e2 * RPE + s2v];
                    asm volatile("" : "+v"(ya[0]), "+v"(ya[1]), "+v"(ya[2]), "+v"(ya[3]), "+v"(ya[4]), "+v"(ya[5]), "+v"(ya[6]), "+v"(ya[7]), "+v"(yb[0]), "+v"(yb[1]), "+v"(yb[2]), "+v"(yb[3]),
                                 "+v"(yb[4]), "+v"(yb[5]), "+v"(yb[6]), "+v"(yb[7]), "+v"(g1), "+v"(g2));
                } else { g1 = GSL[(size_t)e1 * RPE + sl1]; g2 = two ? GSL[(size_t)e2 * RPE + sl2] : 0.f; }
#pragma unroll
                for (int j = 0; j < 8; ++j) { acc[j][0] += g1 * bflo(ya[j].x); acc[j][1] += g1 * bfhi(ya[j].x); acc[j][2] += g1 * bflo(ya[j].y); acc[j][3] += g1 * bfhi(ya[j].y); }
                if (two) {
#pragma unroll
                    for (int j = 0; j < 8; ++j) { acc[j][0] += g2 * bflo(yb[j].x); acc[j][1] += g2 * bfhi(yb[j].x); acc[j][2] += g2 * bflo(yb[j].y); acc[j][3] += g2 * bfhi(yb[j].y); } }
            }
            if (MODE == 2) {
#pragma unroll
                for (int j = 0; j < 8; ++j) { v[j] += vG[j] * acc[j]; *(f32x4*)(xo + 256 * j + ko) = v[j]; }
            } else { const float* mg = MOD + ((size_t)lc * 9 + s) * (6 * D) + 5 * D; const float* bg = a.b_ada + (size_t)lc * 6 * D + 5 * D;
#pragma unroll
                for (int hq = 0; hq < 2; ++hq) { f32x4 g0[4], g1[4];
#pragma unroll
                    for (int jj = 0; jj < 4; ++jj) { g0[jj] = *(const f32x4*)(mg + 256 * (4 * hq + jj) + ko); g1[jj] = *(const f32x4*)(bg + 256 * (4 * hq + jj) + ko); }
                    asm volatile("" : "+v"(g0[0]), "+v"(g0[1]), "+v"(g0[2]), "+v"(g0[3]), "+v"(g1[0]), "+v"(g1[1]), "+v"(g1[2]), "+v"(g1[3]));
#pragma unroll
                    for (int jj = 0; jj < 4; ++jj) { const int j = 4 * hq + jj; v[j] += (g0[jj] + g1[jj]) * acc[j]; *(f32x4*)(xo + 256 * j + ko) = v[j]; } }
            }
        }
        if (MODE != 2) {
            float ss = 0.f;
#pragma unroll
            for (int j = 0; j < 8; ++j) ss += (v[j][0] * v[j][0] + v[j][1] * v[j][1]) + (v[j][2] * v[j][2] + v[j][3] * v[j][3]);
            const float rs = 1.0f / sqrtf(wave_sum(ss) * (1.0f / D) + EPS);
#pragma unroll
            for (int j = 0; j < 8; ++j) { v[j] = (v[j] * rs) * vA[j] + vB[j];
                if (MODE == 1) *(unsigned*)((unsigned char*)H + (size_t)m * D + 256 * j + ko) = cvt4_fp8(v[j][0], v[j][1], v[j][2], v[j][3]);
                else { u32x2 o; o.x = cvt_pk(v[j][0], v[j][1]); o.y = cvt_pk(v[j][2], v[j][3]); *(u32x2*)(H + (size_t)m * D + 256 * j + ko) = o;
                    *(unsigned*)(a.ws + WS_H8 + (size_t)m * D + 256 * j + ko) = cvt4_fp8(v[j][0], v[j][1], v[j][2], v[j][3]); } }
            if (MODE == 1) {
                float p[NE];
#pragma unroll
                for (int e = 0; e < NE; ++e) { float q = 0.f;
#pragma unroll
                    for (int j = 0; j < 8; ++j) { const f32x4 w = *(const LAS f32x4*)(WR + e * D + 256 * j + ko); q += (v[j][0] * w[0] + v[j][1] * w[1]) + (v[j][2] * w[2] + v[j][3] * w[3]); }
                    p[e] = q; if (e & 1) __builtin_amdgcn_sched_barrier(0); }
                float r1[8], r2[4], r3[2], r4;
                { const bool hi = (F.lane & 32) != 0;
#pragma unroll
                  for (int i = 0; i < 8; ++i) { const float keep = hi ? p[8 + i] : p[i], send = hi ? p[i] : p[8 + i]; r1[i] = keep + shx(send, 32); } }
                { const bool hi = (F.lane & 16) != 0;
#pragma unroll
                  for (int i = 0; i < 4; ++i) { const float keep = hi ? r1[4 + i] : r1[i], send = hi ? r1[i] : r1[4 + i]; r2[i] = keep + shx(send, 16); } }
                { const bool hi = (F.lane & 8) != 0;
#pragma unroll
                  for (int i = 0; i < 2; ++i) { const float keep = hi ? r2[2 + i] : r2[i], send = hi ? r2[i] : r2[2 + i]; r3[i] = keep + shx(send, 8); } }
                { const bool hi = (F.lane & 4) != 0; const float keep = hi ? r3[1] : r3[0], send = hi ? r3[0] : r3[1]; r4 = keep + shx(send, 4); }
                r4 += shx(r4, 2); r4 += shx(r4, 1);
                float mx = r4;
                mx = fmaxf(mx, shx(mx, 4)); mx = fmaxf(mx, shx(mx, 8)); mx = fmaxf(mx, shx(mx, 16)); mx = fmaxf(mx, shx(mx, 32));
                const float ex = __expf(r4 - mx); float den = ex;
                den += shx(den, 4); den += shx(den, 8); den += shx(den, 16); den += shx(den, 32);
                const int e = ((F.lane >> 5) & 1) * 8 + ((F.lane >> 4) & 1) * 4 + ((F.lane >> 3) & 1) * 2 + ((F.lane >> 2) & 1);
                const int set = isctx ? 8 + ((m - ML) >> 8) : (m >> 12); const int n = isctx ? ((m - ML) & 255) : (m & 4095);
                if ((F.lane & 3) == 0) __hip_atomic_store(AFF + ((size_t)set * NE + e) * SEQ + n, ex / den, __ATOMIC_RELAXED, __HIP_MEMORY_SCOPE_AGENT);
            }
        }
        if (MODE != 3) {
#pragma unroll
            for (int j = 0; j < 8; ++j) v[j] = vn[j];
        } else if (m + 1 < m1) { const int mn = m + 1; const float* xin = mn >= ML ? xc_in + (size_t)(mn - ML) * D : xl_in + (size_t)mn * D;
#pragma unroll
            for (int j = 0; j < 8; ++j) v[j] = *(const f32x4*)(xin + 256 * j + ko); }
    }
}

__device__ __forceinline__ void convpool_phase(const Frame& F, const Args& a, int l, int nrows) {
    const bf16* P = (const bf16*)(a.ws + WS_P); const bf16* GB = (const bf16*)(a.ws + WS_GB); const bf16* ZP = (const bf16*)(a.ws + WS_ZP); bf16* BR = (bf16*)(a.ws + WS_BR);
    const float* cw = a.conv_w + (size_t)l * 3 * MIXW;
    const int gw = F.c * 8 + F.wave, NGW = F.G * 8; const int ch = F.lane * 8; const int nruns = nrows / 8, npruns = nrows / 4;
    const int g = ch >> 7, win = 2 << g, wlo = win / 2, whi = win - win / 2 - 1;
#pragma unroll 1
    for (int it = gw; it < nruns + npruns; it += NGW) {
        const bool is_pool = it >= nruns; const int m0 = is_pool ? (it - nruns) * 4 : it * 8; const bool isctx = m0 >= ML;
        const int t0 = isctx ? ((m0 - ML) & 255) : (m0 & 4095); const int n = isctx ? LC : SEQ;
        if (!is_pool) {
            float w0[8], w1[8], w2[8];
#pragma unroll
            for (int q = 0; q < 8; ++q) { w0[q] = cw[ch + q]; w1[q] = cw[MIXW + ch + q]; w2[q] = cw[2 * MIXW + ch + q]; }
            u32x4 pr[10], gb[8]; const u32x4 z = (u32x4){0u, 0u, 0u, 0u};
#pragma unroll
            for (int i = 0; i < 10; ++i) { const int t = t0 - 1 + i; pr[i] = (t >= 0 && t < n) ? *(const u32x4*)(P + (size_t)(m0 - 1 + i) * 512 + ch) : z; }
#pragma unroll
            for (int i = 0; i < 8; ++i) gb[i] = *(const u32x4*)(GB + (size_t)(m0 + i) * 512 + ch);
#pragma unroll
            for (int i = 0; i < 8; ++i) { float o[8];
#pragma unroll
                for (int q = 0; q < 4; ++q) {
                    o[2 * q] = bflo(gb[i][q]) * (w0[2 * q] * bflo(pr[i][q]) + w1[2 * q] * bflo(pr[i + 1][q]) + w2[2 * q] * bflo(pr[i + 2][q]));
                    o[2 * q + 1] = bfhi(gb[i][q]) * (w0[2 * q + 1] * bfhi(pr[i][q]) + w1[2 * q + 1] * bfhi(pr[i + 1][q]) + w2[2 * q + 1] * bfhi(pr[i + 2][q])); }
                u32x4 w; w.x = cvt_pk(o[0], o[1]); w.y = cvt_pk(o[2], o[3]); w.z = cvt_pk(o[4], o[5]); w.w = cvt_pk(o[6], o[7]);
                *(u32x4*)(BR + (size_t)(m0 + i) * D + ch) = w; }
        } else {
            float acc[4][8];
#pragma unroll
            for (int i = 0; i < 4; ++i)
#pragma unroll
                for (int q = 0; q < 8; ++q) acc[i][q] = 0.f;
            u32x4 self[4];
#pragma unroll
            for (int r = 0; r < 19; ++r) { const int t = t0 - 8 + r; const bool inr = (t >= 0 && t < n);
                u32x4 zr = (u32x4){0u, 0u, 0u, 0u}; if (inr) zr = *(const u32x4*)(ZP + (size_t)(m0 - 8 + r) * 512 + ch);
                if (r >= 8 && r < 12) self[r - 8] = zr;
                float f[8];
#pragma unroll
                for (int q = 0; q < 4; ++q) { f[2 * q] = bflo(zr[q]); f[2 * q + 1] = bfhi(zr[q]); }
#pragma unroll
                for (int i = 0; i < 4; ++i) { const int d = r - 8 - i;
                    if (d >= -8 && d <= 7) { const bool use = (d >= -wlo) && (d <= whi);
#pragma unroll
                        for (int q = 0; q < 8; ++q) acc[i][q] += use ? f[q] : 0.f; } }
                if ((r & 7) == 7) __builtin_amdgcn_sched_barrier(0); }
#pragma unroll
            for (int i = 0; i < 4; ++i) { const int t = t0 + i; int lo = t - wlo; lo = lo < 0 ? 0 : lo; int hi = t + whi; hi = hi > n - 1 ? n - 1 : hi; const float ic = 1.0f / (float)(hi - lo + 1);
                float o[8];
#pragma unroll
                for (int q = 0; q < 4; ++q) { o[2 * q] = acc[i][2 * q] * ic - bflo(self[i][q]); o[2 * q + 1] = acc[i][2 * q + 1] * ic - bfhi(self[i][q]); }
                u32x4 w; w.x = cvt_pk(o[0], o[1]); w.y = cvt_pk(o[2], o[3]); w.z = cvt_pk(o[4], o[5]); w.w = cvt_pk(o[6], o[7]);
                *(u32x4*)(BR + (size_t)(m0 + i) * D + 1536 + ch) = w; }
        }
    }
}

template <bool LOCAL>
__device__ __forceinline__ void attn_step(const bf16x8 (&kf)[2][2], const u32x4 (&vf)[4], const bf16x8 q0, const bf16x8 q1, const LAS float* rpbrow, const bool (&okA)[2][4],
                                          f32x4 (&o)[4], const float negB, float& lrun) {
    f32x4 s0 = (f32x4){0.f, 0.f, 0.f, 0.f}, s1 = s0;
    s0 = __builtin_amdgcn_mfma_f32_16x16x32_bf16(kf[0][0], q0, s0, 0, 0, 0); s0 = __builtin_amdgcn_mfma_f32_16x16x32_bf16(kf[0][1], q1, s0, 0, 0, 0);
    s1 = __builtin_amdgcn_mfma_f32_16x16x32_bf16(kf[1][0], q0, s1, 0, 0, 0); s1 = __builtin_amdgcn_mfma_f32_16x16x32_bf16(kf[1][1], q1, s1, 0, 0, 0);
    if (LOCAL) {
#pragma unroll
        for (int j = 0; j < 4; ++j) { const float b0 = rpbrow[j], b1 = rpbrow[4 + j]; const float t0 = s0[j] + b0, t1 = s1[j] + b1;
            s0[j] = okA[0][j] ? t0 : -1e30f; s1[j] = okA[1][j] ? t1 : -1e30f; }
    }
    else {
#pragma unroll
        for (int j = 0; j < 4; ++j) { s0[j] += negB; s1[j] += negB; }
    }
#pragma unroll
    for (int j = 0; j < 4; ++j) { s0[j] = __builtin_amdgcn_exp2f(s0[j]); s1[j] = __builtin_amdgcn_exp2f(s1[j]); }
    lrun += ((s0[0] + s0[1]) + (s0[2] + s0[3])) + ((s1[0] + s1[1]) + (s1[2] + s1[3]));
    u32x4 pw; pw.x = cvt_pk(s0[0], s0[1]); pw.y = cvt_pk(s0[2], s0[3]); pw.z = cvt_pk(s1[0], s1[1]); pw.w = cvt_pk(s1[2], s1[3]);
    const bf16x8 pb = __builtin_bit_cast(bf16x8, pw);
#pragma unroll
    for (int dt = 0; dt < 4; ++dt) o[dt] = __builtin_amdgcn_mfma_f32_16x16x32_bf16(__builtin_bit_cast(bf16x8, vf[dt]), pb, o[dt], 0, 0, 0);
}
template <bool LOCAL>
__device__ __forceinline__ void attn_group(const Frame& F, const Args& a, const LAS float* rpbL, const float negB, int b, int h, int rg, int nb) {
    const bf16* Q = (const bf16*)(a.ws + WS_Q); const char* KB = (const char*)(a.ws + WS_KB); const char* VT = (const char*)(a.ws + WS_VT);
    bf16* BR = (bf16*)(a.ws + WS_BR);
    LAS unsigned char* ring = F.lds + F.wave * 16384;
    const int lane = fresh_tid(0), kl = lane & 15, kq = lane >> 4;
    const unsigned qrow0 = LOCAL ? (unsigned)(b * SEQ + 64 * (4 * rg) + 16 * nb + kl) : (unsigned)(ML + b * LC + 64 * rg + kl); constexpr unsigned QSTEP = LOCAL ? 64u : 16u;
    bf16x8 q0[4], q1[4];
#pragma unroll
    for (int qi = 0; qi < 4; ++qi) { const bf16x8* qp = (const bf16x8*)(Q + (size_t)(qrow0 + QSTEP * qi) * 512 + 64 * h + 16 * kq); q0[qi] = qp[0]; q1[qi] = qp[1]; }
    f32x4 o[4][4]; float lrun[4];
#pragma unroll
    for (int qi = 0; qi < 4; ++qi) { lrun[qi] = 0.f;
#pragma unroll
        for (int dt = 0; dt < 4; ++dt) o[qi][dt] = (f32x4){0.f, 0.f, 0.f, 0.f}; }
    bool okA[2][4]; const LAS float* rpbl = rpbL; int rlo = 0, nloc = 0; unsigned kcur, vcur;
    const unsigned dkc = (unsigned)(((lane & 7) ^ ((lane >> 4) & 1)) * 16), dvc = (unsigned)(((lane & 3) ^ ((lane >> 4) & 3)) * 16);
    const unsigned rdk = (unsigned)((8 * (kl >> 2) + (kl & 3)) * 128 + (((2 * kq) ^ (((kl >> 2) << 1) | ((kl >> 1) & 1))) * 16)), rdv = (unsigned)(4096 + kl * 64 + ((kq ^ (kl >> 2)) * 16));
    if (LOCAL) {
        int kbs = 16 * nb - 8; kbs = kbs < 0 ? 0 : (kbs > 32 ? 32 : kbs);
        const int qcol = 16 * nb + kl; int cs = qcol - 8; cs = cs < 0 ? 0 : (cs > 48 ? 48 : cs);
        const int dc0 = kbs + 8 * kq - qcol + 15;
        rpbl = rpbL + h * 480 + dc0;
#pragma unroll
        for (int hf = 0; hf < 2; ++hf)
#pragma unroll
            for (int j = 0; j < 4; ++j) { const int kc = kbs + 8 * kq + 4 * hf + j; okA[hf][j] = (kc >= cs) && (kc < cs + 16); }
        rlo = 4 * rg - 4; rlo = rlo < 0 ? 0 : (rlo > 56 ? 56 : rlo); int rhi = 4 * rg + 3 - 4; rhi = rhi < 0 ? 0 : (rhi > 56 ? 56 : rhi); rhi += 7; nloc = rhi - rlo + 1;
        kcur = (unsigned)(((b * SEQ + 64 * rlo + kbs + (lane >> 3)) * 512 + 64 * h) * 2) + dkc; vcur = (unsigned)((((b * NH + h) * HD + (lane >> 2)) * SEQ + 64 * rlo + kbs) * 2) + dvc;
    } else {
        kcur = (unsigned)(((ML + b * LC + (lane >> 3)) * 512 + 64 * h) * 2) + dkc; vcur = (unsigned)SZ_VT + (unsigned)((((b * NH + h) * HD + (lane >> 2)) * LC) * 2) + dvc;
    }
    const int ntot = nloc + 8;
    int pi = 0;
#define ATT_ISSUE() { const bool loc = LOCAL && (pi < nloc); const unsigned vs = loc ? (unsigned)(16 * SEQ * 2) : (unsigned)(16 * LC * 2); \
        LAS unsigned* dst = (LAS unsigned*)(ring + (pi & 1) * 8192); \
        _Pragma("unroll") for (int pc = 0; pc < 4; ++pc) __builtin_amdgcn_global_load_lds((const unsigned*)(KB + ((kcur ^ (unsigned)(pc * 32)) + (unsigned)(pc * 8192))), dst + pc * 256, 16, 0, 0); \
        _Pragma("unroll") for (int dt = 0; dt < 4; ++dt) __builtin_amdgcn_global_load_lds((const unsigned*)(VT + (vcur + (unsigned)dt * vs)), dst + (4 + dt) * 256, 16, 0, 0); \
        ++pi; \
        if (LOCAL && pi == nloc) { const int l3 = fresh_tid(0); \
            kcur = (unsigned)(((ML + b * LC + (l3 >> 3)) * 512 + 64 * h) * 2) + (unsigned)(((l3 & 7) ^ ((l3 >> 4) & 1)) * 16); \
            vcur = (unsigned)SZ_VT + (unsigned)((((b * NH + h) * HD + (l3 >> 2)) * LC) * 2) + (unsigned)(((l3 & 3) ^ ((l3 >> 4) & 3)) * 16); } \
        else { kcur += loc ? 65536u : 32768u; vcur += loc ? 128u : 64u; } }
    ATT_ISSUE() ATT_ISSUE()
    __builtin_amdgcn_s_waitcnt(0x4F70);
#define ATT_ROW_BEGIN() \
        if (ci + 1 < ntot) asm volatile("s_waitcnt vmcnt(8)" ::: "memory"); else asm volatile("s_waitcnt vmcnt(0)" ::: "memory"); \
        bf16x8 kf[2][2]; u32x4 vf[4]; \
        { LAS unsigned char* sl = ring + (ci & 1) * 8192; \
          kf[0][0] = *(const LAS bf16x8*)(sl + rdk); kf[0][1] = *(const LAS bf16x8*)(sl + (rdk ^ 16u)); kf[1][0] = *(const LAS bf16x8*)(sl + rdk + 512); kf[1][1] = *(const LAS bf16x8*)(sl + (rdk ^ 16u) + 512); \
          _Pragma("unroll") for (int dt = 0; dt < 4; ++dt) vf[dt] = *(const LAS u32x4*)(sl + rdv + dt * 1024); }
#define ATT_ROW_END() \
        asm volatile("s_waitcnt lgkmcnt(0)" ::: "memory"); \
        if (pi < ntot) ATT_ISSUE()
    int ci = 0;
    if (LOCAL) {
#pragma unroll 1
        for (; ci < nloc; ++ci) {
            ATT_ROW_BEGIN()
            const int kr = rlo + ci;
#pragma unroll
            for (int qi = 0; qi < 4; ++qi) { const int r = 4 * rg + qi; int rs = r - 4; rs = rs < 0 ? 0 : (rs > 56 ? 56 : rs);
                if (kr >= rs && kr < rs + 8) attn_step<true>(kf, vf, q0[qi], q1[qi], rpbl + (kr - r + 7) * 32, okA, o[qi], negB, lrun[qi]); }
            ATT_ROW_END()
        }
    }
#pragma unroll 1
    for (; ci < ntot; ++ci) {
        ATT_ROW_BEGIN()
#pragma unroll
        for (int qi = 0; qi < 4; ++qi) attn_step<false>(kf, vf, q0[qi], q1[qi], rpbL, okA, o[qi], negB, lrun[qi]);
        ATT_ROW_END()
    }
#undef ATT_ROW_BEGIN
#undef ATT_ROW_END
#undef ATT_ISSUE
    const int lane2 = fresh_tid(0), kl2 = lane2 & 15, kq2 = lane2 >> 4;
    const unsigned qrow2 = LOCAL ? (unsigned)(b * SEQ + 64 * (4 * rg) + 16 * nb + kl2) : (unsigned)(ML + b * LC + 64 * rg + kl2);
#pragma unroll
    for (int qi = 0; qi < 4; ++qi) { float l = lrun[qi];
        l += __builtin_bit_cast(float, __builtin_amdgcn_ds_bpermute((lane2 ^ 16) << 2, __builtin_bit_cast(int, l))); l += __builtin_bit_cast(float, __builtin_amdgcn_ds_bpermute((lane2 ^ 32) << 2, __builtin_bit_cast(int, l)));
        const float il = 1.0f / l;
#pragma unroll
        for (int dt = 0; dt < 4; ++dt) { u32x2 w; w.x = cvt_pk(o[qi][dt][0] * il, o[qi][dt][1] * il); w.y = cvt_pk(o[qi][dt][2] * il, o[qi][dt][3] * il);
            *(u32x2*)(BR + (size_t)(qrow2 + QSTEP * qi) * D + 512 + 64 * h + 16 * dt + 4 * kq2) = w; } }
}
__device__ __forceinline__ void attn_phase(const Frame& F, const Args& a, int l, bool do_ctx) {
    LAS float* rpbL = (LAS float*)(F.lds + IDX_OFF) + 64;
    __syncthreads();
    {   float rv[8];
#pragma unroll
        for (int u = 0; u < 8; ++u) { const int i = F.tid + 512 * u, h = i / 480, r = (i % 480) >> 5, cdx = i & 31; rv[u] = (i < NH * 15 * 32 && cdx < 31) ? a.na_rpb[(((size_t)l * NH + h) * 15 + r) * 31 + cdx] * LOG2E : 0.f; }
#pragma unroll
        for (int u = 0; u < 8; ++u) { const int i = F.tid + 512 * u; if (i < NH * 15 * 32) rpbL[i] = rv[u]; } }
    __syncthreads();
    float negB;
    { float mq = 0.f, mk = 0.f, mb = 0.f; const float* qw = a.q_norm_w + (size_t)l * HD; const float* kw = a.k_norm_w + (size_t)l * HD;
      mq = fabsf(qw[F.lane]); mk = fabsf(kw[F.lane]);
      for (int i = F.lane; i < NH * 15 * 32; i += 64) mb = fmaxf(mb, fabsf(rpbL[i]));
#pragma unroll
      for (int o = 1; o < 64; o <<= 1) { const int src = (F.lane ^ o) << 2;
          mq = fmaxf(mq, __builtin_bit_cast(float, __builtin_amdgcn_ds_bpermute(src, __builtin_bit_cast(int, mq)))); mk = fmaxf(mk, __builtin_bit_cast(float, __builtin_amdgcn_ds_bpermute(src, __builtin_bit_cast(int, mk))));
          mb = fmaxf(mb, __builtin_bit_cast(float, __builtin_amdgcn_ds_bpermute(src, __builtin_bit_cast(int, mb)))); }
      negB = -(64.0f * 0.125f * LOG2E * mq * mk * 1.02f + mb + 0.5f);
      negB = __builtin_bit_cast(float, __builtin_amdgcn_readfirstlane(__builtin_bit_cast(int, negB))); }
    __syncthreads();
    for (int i = F.tid; i < NH * 15 * 32; i += 512) rpbL[i] += negB;
    __syncthreads();
#pragma unroll 1
    for (int id = F.c * 8 + F.wave; id < NB * NH * 16 * 4; id += F.G * 8) {
        const int nb = id & 3, rg = (id >> 2) & 15, h = (id >> 6) & 7, b = id >> 9;
        attn_group<true>(F, a, rpbL, negB, b, h, rg, nb);
    }
    if (do_ctx) {
#pragma unroll 1
        for (int id = F.c * 8 + F.wave; id < NB * NH * 4; id += F.G * 8) {
            const int g = id & 3, h = (id >> 2) & 7, b = id >> 5;
            attn_group<false>(F, a, rpbL, negB, b, h, g, 0);
        }
    }
    __syncthreads();
}

__device__ __forceinline__ void fft_tables(const Frame& F, LAS float* t64, LAS float* tw) {
    __syncthreads();
    if (F.tid < 64) { float sv, cv; sincospif((float)F.tid * (2.0f / 64.0f), &sv, &cv); t64[2 * F.tid] = cv; t64[2 * F.tid + 1] = sv; }
    if (tw) for (int i = F.tid; i < 4096; i += 512) { float sv, cv; sincospif((float)i * (2.0f / 4096.0f), &sv, &cv); tw[2 * i] = cv; tw[2 * i + 1] = sv; }
    __syncthreads();
}
__device__ __forceinline__ void fft_stage1(const Frame& F, const Args& a) {
    LAS float* t64 = (LAS float*)F.lds; LAS float* tw = (LAS float*)(F.lds + 1024);
    fft_tables(F, t64, tw);
    const bf16* TT2 = (const bf16*)(a.ws + WS_TT); bf16* S2 = (bf16*)(a.ws + WS_S2);
    const int c = F.lane & 15, kq = F.lane >> 4;
    bf16x8 wf[8][4];
#pragma unroll
    for (int j = 0; j < 8; ++j)
#pragma unroll
        for (int st = 0; st < 4; ++st) { float v[8];
#pragma unroll
            for (int i = 0; i < 8; ++i) { const int col = 16 * j + c, k1 = col >> 1, ro = col & 1, kk = 32 * st + 8 * kq + i, part = kk >> 6, n1 = kk & 63, idx = (k1 * n1) & 63;
                const float cs = t64[2 * idx], sn = t64[2 * idx + 1]; v[i] = ro == 0 ? (part == 0 ? cs : -sn) : (part == 0 ? -sn : -cs); }
            u32x4 w; w.x = cvt_pk(v[0], v[1]); w.y = cvt_pk(v[2], v[3]); w.z = cvt_pk(v[4], v[5]); w.w = cvt_pk(v[6], v[7]); wf[j][st] = __builtin_bit_cast(bf16x8, w); }
    const int gw = F.c * 8 + F.wave, NGW = F.G * 8;
    bf16x8 af[4];
    { const int T = gw < NB * 512 * 4 ? gw : 0; const int b = T >> 11, cp = (T >> 2) & 511, n2 = 16 * (T & 3) + c; const bf16* ar = TT2 + (((size_t)(b * 512 + cp) * 64 + n2) * 128) + 8 * kq;
#pragma unroll
      for (int st = 0; st < 4; ++st) af[st] = *(const bf16x8*)(ar + 32 * st); }
#pragma unroll 1
    for (int T = gw; T < NB * 512 * 4; T += NGW) {
        const int b = T >> 11, cp = (T >> 2) & 511, n2 = 16 * (T & 3) + c;
        bf16x8 an[4];
        { const int Tn = T + NGW < NB * 512 * 4 ? T + NGW : T; const int bn = Tn >> 11, cpn = (Tn >> 2) & 511, n2n = 16 * (Tn & 3) + c; const bf16* arn = TT2 + (((size_t)(bn * 512 + cpn) * 64 + n2n) * 128) + 8 * kq;
#pragma unroll
          for (int st = 0; st < 4; ++st) an[st] = *(const bf16x8*)(arn + 32 * st); }
        f32x4 acc[8];
#pragma unroll
        for (int j = 0; j < 8; ++j) { acc[j] = (f32x4){0.f, 0.f, 0.f, 0.f};
#pragma unroll
            for (int st = 0; st < 4; ++st) acc[j] = __builtin_amdgcn_mfma_f32_16x16x32_bf16(wf[j][st], af[st], acc[j], 0, 0, 0); }
#pragma unroll
        for (int j = 0; j < 8; ++j)
#pragma unroll
            for (int hh = 0; hh < 2; ++hh) { const int k1 = 8 * j + 2 * kq + hh; const float xr = acc[j][2 * hh], xi = acc[j][2 * hh + 1]; const int mm = k1 * n2;
                const float cs = tw[2 * mm], sn = tw[2 * mm + 1];
                *(unsigned*)(S2 + (((size_t)(b * 64 + k1) * 512 + cp) * 128 + 2 * n2)) = cvt_pk(xr * cs + xi * sn, xi * cs - xr * sn); }
#pragma unroll
        for (int st = 0; st < 4; ++st) af[st] = an[st];
    }
    __syncthreads();
}
__device__ __forceinline__ void fft_stage3(const Frame& F, const Args& a) {
    LAS float* t64 = (LAS float*)F.lds;
    fft_tables(F, t64, nullptr);
    const bf16* S2 = (const bf16*)(a.ws + WS_S2); bf16* BR = (bf16*)(a.ws + WS_BR);
    const int c = F.lane & 15, kq = F.lane >> 4;
    bf16x8 wf[4][4];
#pragma unroll
    for (int j = 0; j < 4; ++j)
#pragma unroll
        for (int st = 0; st < 4; ++st) { float v[8];
#pragma unroll
            for (int i = 0; i < 8; ++i) { const int k2 = 16 * j + c, kk = 32 * st + 8 * kq + i, n2 = kk >> 1, ri = kk & 1, idx = (k2 * n2) & 63; v[i] = t64[2 * idx + ri] * (1.0f / 64.0f); }
            u32x4 w; w.x = cvt_pk(v[0], v[1]); w.y = cvt_pk(v[2], v[3]); w.z = cvt_pk(v[4], v[5]); w.w = cvt_pk(v[6], v[7]); wf[j][st] = __builtin_bit_cast(bf16x8, w); }
    const int gw = F.c * 8 + F.wave, NGW = F.G * 8;
    bf16x8 af[4];
    { const int T = gw < NB * 64 * 32 ? gw : 0; const bf16* ar = S2 + (((size_t)(T >> 5) * 512 + 16 * (T & 31) + c) * 128) + 8 * kq;
#pragma unroll
      for (int st = 0; st < 4; ++st) af[st] = *(const bf16x8*)(ar + 32 * st); }
#pragma unroll 1
    for (int T = gw; T < NB * 64 * 32; T += NGW) {
        const int bk = T >> 5, b = bk >> 6, k1 = bk & 63, cp = 16 * (T & 31) + c;
        bf16x8 an[4];
        { const int Tn = T + NGW < NB * 64 * 32 ? T + NGW : T; const bf16* arn = S2 + (((size_t)(Tn >> 5) * 512 + 16 * (Tn & 31) + c) * 128) + 8 * kq;
#pragma unroll
          for (int st = 0; st < 4; ++st) an[st] = *(const bf16x8*)(arn + 32 * st); }
        f32x4 acc[4];
#pragma unroll
        for (int j = 0; j < 4; ++j) { acc[j] = (f32x4){0.f, 0.f, 0.f, 0.f};
#pragma unroll
            for (int st = 0; st < 4; ++st) acc[j] = __builtin_amdgcn_mfma_f32_16x16x32_bf16(wf[j][st], af[st], acc[j], 0, 0, 0); }
        asm volatile("s_nop 15\n\ts_nop 15" : "+v"(acc[0]), "+v"(acc[1]), "+v"(acc[2]), "+v"(acc[3]));
#pragma unroll
        for (int j = 0; j < 4; ++j)
#pragma unroll
            for (int jj = 0; jj < 4; ++jj) { const int k2 = 16 * j + 4 * kq + jj; BR[((size_t)b * SEQ + k1 + 64 * k2) * D + 1024 + cp] = f2bf(acc[j][jj]); }
#pragma unroll
        for (int st = 0; st < 4; ++st) af[st] = an[st];
    }
    __syncthreads();
}

__device__ __forceinline__ void topk_phase(const Frame& F, const Args& a, int nsets) {
    const float* AFF = (const float*)(a.ws + WS_AFF); float* GSL = (float*)(a.ws + WS_GSL); short* INV = (short*)(a.ws + WS_INV);
    int* SROW = (int*)(a.ws + WS_SROW);
    LAS unsigned* hist = (LAS unsigned*)F.lds;
    LAS unsigned* sh = hist + 256;
    for (int it = F.c; it < nsets * NE; it += F.G) {
        const int set = it / NE, e = it % NE; const bool isctx = set >= 8; const int n = isctx ? LC : SEQ, cap = isctx ? CAPC : CAPL;
        const float* av = AFF + ((size_t)set * NE + e) * SEQ;
        unsigned v[8]; const bool act = F.tid * 8 < n;
#pragma unroll
        for (int q = 0; q < 8; ++q) v[q] = act ? __float_as_uint(av[F.tid * 8 + q]) : 0u;
        unsigned prefix = 0u, pmask = 0u; int krem = cap;
        for (int pass = 0; pass < 4; ++pass) {
            const int shift = 24 - 8 * pass;
            __syncthreads();
            if (F.tid < 256) hist[F.tid] = 0u;
            __syncthreads();
            if (act) {
#pragma unroll
                for (int q = 0; q < 8; ++q) if ((v[q] & pmask) == prefix) __hip_atomic_fetch_add(&hist[(v[q] >> shift) & 255u], 1u, __ATOMIC_RELAXED, __HIP_MEMORY_SCOPE_WORKGROUP);
            }
            __syncthreads();
            if (F.wave == 0) {
                const u32x4 c4 = *(const LAS u32x4*)(hist + 4 * F.lane); const int tot = (int)(c4.x + c4.y + c4.z + c4.w);
                int incl = tot;
#pragma unroll
                for (int o = 1; o < 64; o <<= 1) { const int t = __builtin_amdgcn_ds_bpermute(((F.lane + o) & 63) << 2, incl); if (F.lane + o < 64) incl += t; }
                const int above = incl - tot;
                if (above < krem && krem <= incl) { int k = krem - above; int bin = 4 * F.lane + 3;
                    if ((int)c4.w < k) { k -= (int)c4.w; bin = 4 * F.lane + 2; if ((int)c4.z < k) { k -= (int)c4.z; bin = 4 * F.lane + 1; if ((int)c4.y < k) { k -= (int)c4.y; bin = 4 * F.lane; } } }
                    sh[0] = (unsigned)bin; sh[1] = (unsigned)k; }
            }
            __syncthreads();
            prefix |= sh[0] << shift; pmask |= 255u << shift; krem = (int)sh[1];
        }
        int ngt = 0, neq = 0;
#pragma unroll
        for (int q = 0; q < 8; ++q) { ngt += (act && v[q] > prefix) ? 1 : 0; neq += (act && v[q] == prefix) ? 1 : 0; }
        unsigned pk = (unsigned)ngt | ((unsigned)neq << 16), incl = pk;
#pragma unroll
        for (int o = 1; o < 64; o <<= 1) { const unsigned t = (unsigned)__builtin_amdgcn_ds_bpermute(((F.lane - o) & 63) << 2, (int)incl); if (F.lane >= o) incl += t; }
        __syncthreads();
        if (F.lane == 63) sh[8 + F.wave] = incl;
        __syncthreads();
        unsigned woff = 0u;
        for (int w = 0; w < F.wave; ++w) woff += sh[8 + w];
        const unsigned excl = incl - pk + woff; int gtb = (int)(excl & 0xffffu), eqb = (int)(excl >> 16);
        const int rowE0 = isctx ? NB * CAPL + (set - 8) * CAPC : set * CAPL; const int mrow0 = isctx ? ML + (set - 8) * LC : set * SEQ;
        if (act) {
#pragma unroll
            for (int q = 0; q < 8; ++q) { const bool gt = v[q] > prefix, eq = v[q] == prefix; const bool sel = gt || (eq && eqb < krem);
                const int pos = gtb + (eqb < krem ? eqb : krem); const int mrow = mrow0 + F.tid * 8 + q;
                if (sel) { SROW[(size_t)e * RPE + rowE0 + pos] = mrow; GSL[(size_t)e * RPE + rowE0 + pos] = __uint_as_float(v[q]); }
                __hip_atomic_store(INV + (size_t)mrow * NE + e, sel ? (short)(rowE0 + pos) : (short)-1, __ATOMIC_RELAXED, __HIP_MEMORY_SCOPE_AGENT);
                gtb += gt ? 1 : 0; eqb += eq ? 1 : 0; }
        }
        __syncthreads();
    }
}

__global__ void __launch_bounds__(512, 2) fwd_kernel(Args a_in) {
    extern __shared__ __attribute__((aligned(16))) unsigned char lds_raw[];
    Frame F; F.lds = (LAS unsigned char*)lds_raw; F.tid = threadIdx.x; F.lane = F.tid & 63; F.wave = __builtin_amdgcn_readfirstlane(F.tid >> 6); F.G = gridDim.x; F.c = blockIdx.x;
    volatile LAS unsigned* MISC = (volatile LAS unsigned*)(F.lds + MISC_OFF);
    if (F.tid < 64) MISC[F.tid] = 0u;
    __syncthreads();
    unsigned* ctl = (unsigned*)(a_in.ws + WS_CTL);
    XcdBarrier bar; bar.bar = ctl + 4096; bar.x = 0; bar.st = nullptr;
    if (N_LAUNCH_MODE == 1) bar = xcd_barrier_post(ctl + 4096, MISC + 8);
    const int lo = a_in.ph_lo, hi = a_in.ph_hi;
#define IN(k) (N_LAUNCH_MODE == 1 || (lo <= (k) && (k) < hi))
#define SEAM(k) do { if (IN(k) && IN((k) + 1)) xcd_barrier(bar, F.wave); } while (0)
    if (IN(0)) { ARGS_HERE; unsigned char* ws = a.ws; float* XC = (float*)(ws + WS_XC); (void)XC; const Frame Fp = fresh_frame(F.lds, F.wave); prologue_misc(Fp, a); convert_weights(Fp, a, 0); __syncthreads(); }
    SEAM(0);
    for (int l = 0; l < DEPTH; ++l) {
        const bool last = (l == DEPTH - 1); const int P0 = 1 + 11 * l;
        const int nrow = last ? ML : MT;
        if (IN(P0)) { ARGS_HERE; unsigned char* ws = a.ws; float* XC = (float*)(ws + WS_XC); (void)XC; const Frame Fp = fresh_frame(F.lds, F.wave); if (l > 0) convert_weights(Fp, a, l); if (l == 0) norm_phase<0>(Fp, a, l, a.out, XC, a.x, a.ctx); else norm_phase<3>(Fp, a, l, a.out, XC, a.out, XC); }
        SEAM(P0);
        if (IN(P0 + 1)) {
            ARGS_HERE; unsigned char* ws = a.ws; float* XC = (float*)(ws + WS_XC); (void)XC; pg8::Geo g{ws + WS_H, ws + WS_WIN, D * 2, D * 2, D * 2};
            pg8::RectSched S; S.init(nrow / 256, 8, F.G, F.c); S.pn_split = 6; S.pn_shift = 6;
            if (!last) { S.nextra = 8 * 4; S.extra_pm0 = ML / 256; S.extra_pn0 = 14; S.extra_nn = 4; }
            EpiWin E{(bf16*)(ws + WS_P), (bf16*)(ws + WS_GB), (bf16*)(ws + WS_Q), (bf16*)(ws + WS_KB), (bf16*)(ws + WS_ZP), (bf16*)(ws + WS_VT), (bf16*)(ws + WS_VTC), (bf16*)(ws + WS_TT), (bf16*)(ws + WS_TTC),
                     a.q_norm_w + (size_t)l * HD, a.k_norm_w + (size_t)l * HD};
            pg8::gemm_phase<EpiWin, pg8::RectSched, true>(F.lds, F.wave, g, S, E);
            pg8::TSched ST{F.G, F.c}; EpiWinT ET{(bf16*)(ws + WS_TT), F.lds + IDX_OFF};
            pg8::gemm_phase<EpiWinT, pg8::TSched, true, false, true>(F.lds, F.wave, g, ST, ET);
            pg8::Geo g8{ws + WS_H8, ws + WS_WQKV8, D, D, D};
            pg8::RectSched S8; S8.init(nrow / 256, 6, F.G, F.c);
            if (last) { S8.nextra = 8 * 4; S8.extra_pm0 = ML / 256; S8.extra_pn0 = 2; S8.extra_nn = 4; }
            else if (F.G == 256) { S8.skew_full = 2; S8.skew_c0 = 96; }
            EpiQKV8 E8{(bf16*)(ws + WS_Q), (bf16*)(ws + WS_KB), (bf16*)(ws + WS_VT), (bf16*)(ws + WS_VTC), a.q_norm_w + (size_t)l * HD, a.k_norm_w + (size_t)l * HD, F.lds + IDX_OFF};
            pg8::gemm_phase<EpiQKV8, pg8::RectSched, true, true>(F.lds, F.wave, g8, S8, E8);
        }
        SEAM(P0 + 1);
        if (IN(P0 + 2)) {
            { ARGS_HERE; unsigned char* ws = a.ws; float* XC = (float*)(ws + WS_XC); (void)XC; const Frame Fp = fresh_frame(F.lds, F.wave); convpool_phase(Fp, a, l, nrow); }
            { ARGS_HERE; unsigned char* ws = a.ws; float* XC = (float*)(ws + WS_XC); (void)XC; const Frame Fp = fresh_frame(F.lds, F.wave); attn_phase(Fp, a, l, !last); }
            { ARGS_HERE; unsigned char* ws = a.ws; float* XC = (float*)(ws + WS_XC); (void)XC; const Frame Fp = fresh_frame(F.lds, F.wave); fft_stage1(Fp, a); }
            if (!last) { ARGS_HERE; unsigned char* ws = a.ws; pg8::Geo g{ws + WS_DFTC, ws + WS_TTC, 4 * LC, 4 * LC, 4 * LC}; pg8::FourierCtxSched S{F.G, F.c}; EpiPlain E{(bf16*)(ws + WS_BR), D, 1024};
              pg8::gemm_phase<EpiPlain, pg8::FourierCtxSched, true>(F.lds, F.wave, g, S, E); }
        }
        SEAM(P0 + 2);
        if (IN(P0 + 3)) { ARGS_HERE; unsigned char* ws = a.ws; float* XC = (float*)(ws + WS_XC); (void)XC; const Frame Fp = fresh_frame(F.lds, F.wave); fft_stage3(Fp, a); }
        SEAM(P0 + 3);
        if (IN(P0 + 4)) {
            ARGS_HERE; unsigned char* ws = a.ws; float* XC = (float*)(ws + WS_XC); (void)XC; pg8::Geo g{ws + WS_BR, ws + WS_WBR, 512 * 2, D * 2, D * 2};
            pg8::BranchSched S{nrow / 256, F.G, F.c};
            EpiPlain E{(bf16*)(ws + WS_PB), 4 * D, 0};
            pg8::gemm_phase<EpiPlain, pg8::BranchSched, true>(F.lds, F.wave, g, S, E);
        }
        SEAM(P0 + 4);
        if (IN(P0 + 5)) {
            ARGS_HERE; unsigned char* ws = a.ws; float* XC = (float*)(ws + WS_XC); (void)XC; pg8::Geo g{ws + WS_H8, ws + WS_WG8, D, D, D};
            pg8::RectSched S; S.init(nrow / 256, 32, F.G, F.c);
            EpiGate E{(const bf16*)(ws + WS_PB), (bf16*)(ws + WS_MG)};
            pg8::gemm_phase<EpiGate, pg8::RectSched, true, true>(F.lds, F.wave, g, S, E);
        }
        SEAM(P0 + 5);
        if (IN(P0 + 6)) {
            ARGS_HERE; unsigned char* ws = a.ws; float* XC = (float*)(ws + WS_XC); (void)XC; pg8::Geo g{ws + WS_MG, ws + WS_WOUT, D * 2, D * 2, D * 2};
            pg8::RectSched S; S.init(nrow / 256, D / 256, F.G, F.c);
            EpiWout E{l == 0 ? a.x : a.out, l == 0 ? a.ctx : XC, a.out, XC, (const float*)(ws + WS_MOD) + (size_t)l * 9 * 6 * D, a.b_ada + (size_t)l * 6 * D};
            pg8::gemm_phase<EpiWout, pg8::RectSched, true>(F.lds, F.wave, g, S, E);
        }
        SEAM(P0 + 6);
        if (IN(P0 + 7)) { ARGS_HERE; unsigned char* ws = a.ws; float* XC = (float*)(ws + WS_XC); (void)XC; const Frame Fp = fresh_frame(F.lds, F.wave); norm_phase<1>(Fp, a, l, a.out, XC, a.out, XC); }
        SEAM(P0 + 7);
        if (IN(P0 + 8)) { ARGS_HERE; unsigned char* ws = a.ws; float* XC = (float*)(ws + WS_XC); (void)XC; const Frame Fp = fresh_frame(F.lds, F.wave); topk_phase(Fp, a, last ? 8 : 16); }
        SEAM(P0 + 8);
        if (IN(P0 + 9)) {
            ARGS_HERE; unsigned char* ws = a.ws; float* XC = (float*)(ws + WS_XC); (void)XC; pg8::Geo g{ws + WS_H, ws + WS_WGU, D, D, D, (const int*)(ws + WS_SROW)};
            pg8::ExpertSched S{last ? 16 : PPE, 16, F.G, F.c};
            EpiGU E{ws + WS_HID};
            pg8::gemm_phase<EpiGU, pg8::ExpertSched, true, true, false, true>(F.lds, F.wave, g, S, E);
        }
        SEAM(P0 + 9);
        if (IN(P0 + 10)) {
            ARGS_HERE; unsigned char* ws = a.ws; float* XC = (float*)(ws + WS_XC); (void)XC; pg8::Geo g{ws + WS_HID, ws + WS_WD, FF, FF, FF};
            pg8::ExpertSched S{last ? 16 : PPE, 8, F.G, F.c};
            EpiY E{(bf16*)(ws + WS_Y)};
            pg8::gemm_phase<EpiY, pg8::ExpertSched, true, true>(F.lds, F.wave, g, S, E);
        }
        SEAM(P0 + 10);
    }
    if (IN(23)) { ARGS_HERE; unsigned char* ws = a.ws; float* XC = (float*)(ws + WS_XC); (void)XC; const Frame Fp = fresh_frame(F.lds, F.wave); norm_phase<2>(Fp, a, DEPTH - 1, a.out, XC, a.out, XC); }
#undef IN
#undef SEAM
}

extern "C" void kernel_launch(void* const* d_in, const int* in_sizes, int n_in, void* d_out, int out_size, void* d_ws, size_t ws_size, hipStream_t stream) {
    static int grid = 0;
    if (grid == 0) {
        if (n_in != 21 || out_size != ML * D || ws_size < WS_END) { fprintf(stderr, "kernel_launch: unexpected shapes (n_in %d out %d ws %zu need %zu)\n", n_in, out_size, ws_size, (size_t)WS_END); grid = -1; return; }
        int dev = 0, cus = 0;
        if (hipGetDevice(&dev) != hipSuccess || hipDeviceGetAttribute(&cus, hipDeviceAttributeMultiprocessorCount, dev) != hipSuccess) { grid = -1; return; }
        if (hipFuncSetAttribute((const void*)fwd_kernel, hipFuncAttributeMaxDynamicSharedMemorySize, LDS_BYTES) != hipSuccess) { fprintf(stderr, "kernel_launch: hipFuncSetAttribute failed\n"); grid = -1; return; }
        int per_cu = 0;
        if (hipOccupancyMaxActiveBlocksPerMultiprocessor(&per_cu, (const void*)fwd_kernel, 512, LDS_BYTES) != hipSuccess || per_cu < 1) fprintf(stderr, "kernel_launch: occupancy query says %d\n", per_cu);
        (void)hipGetLastError();
        grid = cus;
    }
    if (grid < 0) return;
    (void)hipMemsetAsync((char*)d_ws + WS_CTL, 0, ZERO_BYTES, stream);
    Args a{};
    const float** ap = (const float**)&a;
    for (int i = 0; i < 21; ++i) ap[i] = (const float*)d_in[i];
    a.out = (float*)d_out; a.ws = (unsigned char*)d_ws;
    if (N_LAUNCH_MODE == 1) { a.ph_lo = 0; a.ph_hi = NPHASE; hipLaunchKernelGGL(fwd_kernel, dim3(grid), dim3(512), LDS_BYTES, stream, a); }
    else { for (int p = 0; p < NPHASE; ++p) { a.ph_lo = p; a.ph_hi = p + 1; hipLaunchKernelGGL(fwd_kernel, dim3(grid), dim3(512), LDS_BYTES, stream, a); } }
}
```

```cpp
#include <hip/hip_runtime.h>
#include <cstdio>
#include <cstdint>

#define LAS __attribute__((address_space(3)))
#define GAS __attribute__((address_space(1)))
typedef unsigned short bf16;
typedef short bf16x8 __attribute__((ext_vector_type(8)));
typedef short s16x4 __attribute__((ext_vector_type(4)));
typedef float f32x4 __attribute__((ext_vector_type(4)));
typedef float f32x2 __attribute__((ext_vector_type(2)));
typedef unsigned u32x4 __attribute__((ext_vector_type(4)));
typedef unsigned u32x2 __attribute__((ext_vector_type(2)));

#ifndef N_LAUNCH_MODE
#define N_LAUNCH_MODE 1
#endif

constexpr int D = 2048, NB = 8, SEQ = 4096, LC = 256, DEPTH = 2;
constexpr int ML = NB * SEQ, MC = NB * LC, MT = ML + MC;
constexpr int MIXW = 512, NH = 8, HD = 64, NE = 16, FF = 2048;
constexpr int INC = 12288;
constexpr int NZT = 50, NZ = NZT * 256;
constexpr int CAPL = 512, CAPC = 32, RPE = NB * CAPL + NB * CAPC;
constexpr int PPE = RPE / 256;
constexpr float EPS = 1e-6f;
constexpr float LOG2E = 1.4426950408889634f;
constexpr int NPHASE = 24;

constexpr size_t al(size_t x) { return (x + 4095) & ~(size_t)4095; }
constexpr size_t WS_CTL = 0, CTL_BYTES = 1u << 20;
constexpr size_t WS_MOD = CTL_BYTES, MOD_BYTES = al((size_t)DEPTH * 9 * 6 * D * 4);
constexpr size_t ZERO_BYTES = WS_MOD + MOD_BYTES;
constexpr size_t WS_WIN = ZERO_BYTES, SZ_WIN = (size_t)NZ * D * 2;
constexpr size_t WS_WBR = WS_WIN + SZ_WIN, SZ_WBR = (size_t)D * D * 2;
constexpr size_t WS_WOUT = WS_WBR + SZ_WBR, SZ_WOUT = (size_t)D * D * 2;
constexpr size_t WS_WGU = WS_WOUT + SZ_WOUT, SZ_WGU = (size_t)NE * 2 * FF * D * 2;
constexpr size_t WS_WD = WS_WGU + SZ_WGU, SZ_WD = (size_t)NE * D * FF * 2;
constexpr size_t WS_DFTC = WS_WD + SZ_WD, SZ_DFTC = (size_t)LC * 2 * LC * 2;
constexpr size_t WS_H = WS_DFTC + SZ_DFTC, SZ_H = (size_t)MT * D * 2;
constexpr size_t WS_H8 = WS_H + SZ_H, SZ_H8 = (size_t)MT * D;
constexpr size_t WS_WG8 = WS_H8 + SZ_H8, SZ_WG8 = (size_t)8192 * D;
constexpr size_t WS_WQKV8 = WS_WG8 + SZ_WG8, SZ_WQKV8 = (size_t)6 * 256 * D;
constexpr size_t WS_XC = WS_WQKV8 + SZ_WQKV8, SZ_XC = (size_t)MC * D * 4;
constexpr size_t WS_AFF = WS_XC + SZ_XC, SZ_AFF = (size_t)16 * NE * SEQ * 4;
constexpr size_t WS_GSL = WS_AFF + SZ_AFF, SZ_GSL = al((size_t)NE * RPE * 4);
constexpr size_t WS_SROW = WS_GSL + SZ_GSL, SZ_SROW = al((size_t)NE * RPE * 4);
constexpr size_t WS_INV = WS_SROW + SZ_SROW, SZ_INV = al((size_t)MT * NE * 2);
constexpr size_t WS_R1 = WS_INV + SZ_INV;
constexpr size_t SZ_PB = (size_t)MT * 8192 * 2, SZ_HID = (size_t)NE * RPE * D;
constexpr size_t WS_PB = WS_R1, WS_HID = WS_R1;
constexpr size_t SZ_R1 = SZ_PB > SZ_HID ? SZ_PB : SZ_HID;
constexpr size_t WS_R2 = WS_R1 + SZ_R1;
constexpr size_t SZ_T512 = (size_t)MT * 512 * 2;
constexpr size_t WS_P = WS_R2, WS_GB = WS_P + SZ_T512, WS_Q = WS_GB + SZ_T512, WS_KB = WS_Q + SZ_T512, WS_ZP = WS_KB + SZ_T512;
constexpr size_t WS_VT = WS_ZP + SZ_T512, SZ_VT = (size_t)NB * NH * HD * SEQ * 2, WS_VTC = WS_VT + SZ_VT, SZ_VTC = (size_t)NB * NH * HD * LC * 2;
constexpr size_t WS_TT = WS_VTC + SZ_VTC, SZ_TT = (size_t)NB * 512 * 2 * SEQ * 2, WS_TTC = WS_TT + SZ_TT, SZ_TTC = (size_t)NB * 512 * 2 * LC * 2;
constexpr size_t WS_BR = WS_TTC + SZ_TTC, SZ_BR = (size_t)MT * D * 2, WS_MG = WS_BR + SZ_BR;
constexpr size_t WS_Y = WS_R2, SZ_Y = (size_t)NE * RPE * D * 2;
constexpr size_t WS_S2 = WS_MG + SZ_BR, SZ_S2 = (size_t)NB * 64 * 512 * 128 * 2;
constexpr size_t WS_END = WS_S2 + SZ_S2;
static_assert(WS_Y + SZ_Y <= WS_END, "Y overlay");
static_assert(WS_END < (size_t)2250 * 1024 * 1024, "workspace budget");

constexpr int RING_BYTES = 131072, MISC_OFF = RING_BYTES, IDX_OFF = MISC_OFF + 1024, LDS_BYTES = 163840;

typedef __bf16 bf16x2_t __attribute__((ext_vector_type(2)));
__device__ __forceinline__ unsigned cvt_pk(float lo, float hi) { const f32x2 v = {lo, hi}; const bf16x2_t b = __builtin_convertvector(v, bf16x2_t); return __builtin_bit_cast(unsigned, b); }
__device__ __forceinline__ bf16 f2bf(float f) { const __bf16 b = (__bf16)f; return __builtin_bit_cast(unsigned short, b); }
__device__ __forceinline__ float bflo(unsigned u) { return __uint_as_float(u << 16); }
__device__ __forceinline__ float bfhi(unsigned u) { return __uint_as_float(u & 0xffff0000u); }
__device__ __forceinline__ int lane_now() { int l; asm volatile("v_mbcnt_lo_u32_b32 %0, -1, 0\n\tv_mbcnt_hi_u32_b32 %0, -1, %0" : "=v"(l)); return l; }
__device__ __forceinline__ float shx(float v, int o) { return __builtin_bit_cast(float, __builtin_amdgcn_ds_bpermute((lane_now() ^ o) << 2, __builtin_bit_cast(int, v))); }
__device__ __forceinline__ float wave_sum(float v) {
#pragma unroll
    for (int o = 1; o < 64; o <<= 1) v += shx(v, o);
    return v;
}
__device__ __forceinline__ float fast_rcp(float x) { return __builtin_amdgcn_rcpf(x); }
__device__ __forceinline__ float sigmoidf_(float x) { return fast_rcp(1.0f + __builtin_amdgcn_exp2f(-x * LOG2E)); }
__device__ __forceinline__ float siluf_(float x) { return x * sigmoidf_(x); }
constexpr float W8SCALE = 64.0f;
__device__ __forceinline__ float clamp8(float x) { return fminf(fmaxf(x, -448.0f), 448.0f); }
__device__ __forceinline__ unsigned cvt4_fp8(float a, float b, float c, float d) { int w = 0; w = __builtin_amdgcn_cvt_pk_fp8_f32(clamp8(a), clamp8(b), w, false); w = __builtin_amdgcn_cvt_pk_fp8_f32(clamp8(c), clamp8(d), w, true); return (unsigned)w; }
#define LDS_WAIT() asm volatile("s_waitcnt lgkmcnt(0)" ::: "memory")
__device__ __forceinline__ int fresh_tid(int wave) { int lane; asm volatile("v_mbcnt_lo_u32_b32 %0, -1, 0\n\tv_mbcnt_hi_u32_b32 %0, -1, %0" : "=v"(lane)); return wave * 64 + lane; }

#define XB_TMO      128
#define XB_XCNT(j)  (256  + 64 * (j))
#define XB_XSUB(j)  (1280 + 64 * (j))
#define XB_XGEN(j)  (2304 + 64 * (j))
#define XB_TOP      3328
#define XB_TOPGEN   3392
#define XCD_BAR_WORDS 3456
#define XB_SPIN_CAP (1u << 22)
__device__ __forceinline__ unsigned xb_ld(unsigned* p)              { return __hip_atomic_load(p, __ATOMIC_RELAXED, __HIP_MEMORY_SCOPE_AGENT); }
__device__ __forceinline__ unsigned xb_add(unsigned* p, unsigned v) { return __hip_atomic_fetch_add(p, v, __ATOMIC_RELAXED, __HIP_MEMORY_SCOPE_AGENT); }
__device__ __forceinline__ unsigned xb_xcc_id() { return (unsigned)__builtin_amdgcn_s_getreg((3 << 11) | 20) & 0xFu; }
#define XB_SPIN(cond, bar) do { unsigned _sp = 0; while (cond) { __builtin_amdgcn_s_sleep(1); \
    if ((++_sp & 255u) == 0u) { if (xb_ld(&(bar)[XB_TMO])) break; if (_sp > XB_SPIN_CAP) { atomicAdd(&(bar)[XB_TMO], 1u); break; } } } } while (0)
struct XcdBarrier { unsigned* bar; unsigned x; volatile LAS unsigned* st; };
__device__ __forceinline__ XcdBarrier xcd_barrier_post(unsigned* bar, volatile LAS unsigned* st) {
    XcdBarrier b; b.bar = bar; b.x = xb_xcc_id(); b.st = st;
    if (threadIdx.x == 0) (void)xb_add(&bar[XB_XCNT(b.x)], 1u);
    return b;
}
__device__ __forceinline__ void xcd_barrier_complete(unsigned* bar, unsigned x, unsigned& nloc, unsigned& nx) {
    const unsigned G = gridDim.x * gridDim.y * gridDim.z;
    unsigned sum, cnt, mine, sp = 0u;
    for (;;) {
        sum = 0u; cnt = 0u; mine = 0u;
        unsigned cs[16];
#pragma unroll
        for (unsigned j = 0; j < 16; ++j) cs[j] = __hip_atomic_load((const GAS unsigned*)&bar[XB_XCNT(j)], __ATOMIC_RELAXED, __HIP_MEMORY_SCOPE_AGENT);
#pragma unroll
        for (unsigned j = 0; j < 16; ++j) { const unsigned c = cs[j]; sum += c; cnt += (c > 0u) ? 1u : 0u; mine = (j == x) ? c : mine; }
        if (sum == G) break;
        __builtin_amdgcn_s_sleep(1);
        if ((++sp & 255u) == 0u) { if (xb_ld(&bar[XB_TMO])) break; if (sp > XB_SPIN_CAP) { atomicAdd(&bar[XB_TMO], 1u); break; } }
    }
    nloc = mine > 0u ? mine : 1u; nx = cnt > 0u ? cnt : 1u;
}
__device__ __forceinline__ void xcd_barrier(const XcdBarrier& b, int wave) {
    asm volatile("s_waitcnt vmcnt(0)" ::: "memory");
    __syncthreads();
    if (fresh_tid(wave) == 0) {
        unsigned* bar = b.bar; asm volatile("" : "+s"(bar));
        unsigned bx = xb_xcc_id(); asm volatile("" : "+s"(bx));
        __builtin_amdgcn_s_waitcnt(0);
        unsigned nloc = b.st[0], nx = b.st[1];
        if (nloc == 0u) { xcd_barrier_complete(bar, bx, nloc, nx); b.st[0] = nloc; b.st[1] = nx; }
        const unsigned old = xb_add(&bar[XB_XSUB(bx)], 1u);
        const unsigned gen = old / nloc;
        if (old + 1u == (gen + 1u) * nloc) {
            __builtin_amdgcn_fence(__ATOMIC_RELEASE, "agent");
            asm volatile("s_waitcnt vmcnt(0)" ::: "memory");
            const unsigned og = xb_add(&bar[XB_TOP], 1u);
            const unsigned tg = og / nx;
            if (og + 1u == (tg + 1u) * nx) xb_add(&bar[XB_TOPGEN], 1u);
            else XB_SPIN(xb_ld(&bar[XB_TOPGEN]) == tg, bar);
            __builtin_amdgcn_fence(__ATOMIC_ACQUIRE, "agent");
            xb_add(&bar[XB_XGEN(bx)], 1u);
            asm volatile("s_waitcnt vmcnt(0)" ::: "memory");
        } else {
            XB_SPIN(xb_ld(&bar[XB_XGEN(bx)]) == gen, bar);
            __builtin_amdgcn_fence(__ATOMIC_ACQUIRE, "agent");
            asm volatile("s_waitcnt vmcnt(0)" ::: "memory");
        }
    }
    __syncthreads();
}

#ifndef PG8_SP2_DEFAULT
#define PG8_SP2_DEFAULT true
#endif
namespace pg8 {
constexpr int BM = 256, BK = 64, HALF = 128, HTB = HALF * BK * 2, STAGE_BYTES = 8 * HTB;
__host__ __device__ __forceinline__ int lds_byte(int r, int c) { const int st = (r >> 4) * 2 + (c >> 5), rr = r & 15, cc = c & 31, ob = rr * 64 + cc * 2; return st * 1024 + (ob ^ (((ob >> 9) & 1) << 5)); }
__host__ __device__ __forceinline__ void stage_rc(int b, int& R, int& C) { const int st = b / 1024, sb = b % 1024, swz = sb ^ (((sb >> 9) & 1) << 5); R = (st >> 1) * 16 + swz / 64; C = (st & 1) * 32 + (swz % 64) / 2; }
__host__ __device__ __forceinline__ int perm32(int rho) { const int n = rho >> 4, i = rho & 15; return 8 * (i >> 2) + 4 * n + (i & 3); }
struct Unit { int pm, pn, am, bn, kofs; };
struct Geo { const void* A; const void* Bt; int Kb; int lda, ldb; const int* arows; };
typedef int i32x8 __attribute__((ext_vector_type(8)));
typedef int i32x4_ __attribute__((ext_vector_type(4)));

template <class Epi, class Sched, bool ALIGN_EPI, bool FP8 = false, bool APERM = false, bool AGATHER = false, bool SP2 = PG8_SP2_DEFAULT>
__device__ __forceinline__ void gemm_phase(LAS unsigned char* lds, int wave, const Geo g, const Sched& S, const Epi& E) {
    const int tid = fresh_tid(wave), wid = wave, lane = tid & 63, wr = wid >> 2, wc = wid & 3, fr = lane & 15, fq = lane >> 4;
    const int nt = g.Kb / 128;
    unsigned voffA[2], voffB[2]; int gR[2], gC[2];
#pragma unroll
    for (int i = 0; i < 2; ++i) { int R, C; stage_rc(tid * 16 + i * 8192, R, C); gR[i] = R; gC[i] = C * 2; const int Rb = Epi::PERM ? ((R & ~31) + perm32(R & 31)) : R;
        const int Ra = APERM ? 64 * (R >> 2) + (R & 3) : R;
        voffA[i] = (unsigned)(Ra * g.lda + C * 2); voffB[i] = (unsigned)(Rb * g.ldb + C * 2); }
    const size_t kstep = (size_t)(BK * 2);
    const size_t hstepA = AGATHER ? 0 : (size_t)(APERM ? 2048 : HALF) * g.lda, hstepB = (size_t)HALF * g.ldb;
    const size_t tstepA = AGATHER ? 0 : (APERM ? (size_t)4 * g.lda : 2 * hstepA), tstepB = 2 * hstepB;
    const unsigned ldsw = (unsigned)wid * 1024u;
    const int aoff = lds_byte(wr * 64 + fr, fq * 8), boff = lds_byte(wc * 32 + fr, fq * 8);
#define PG8_SA(b, h) (((b) * 2 + (h)) * HTB)
#define PG8_SB(b, h) ((4 + (b) * 2 + (h)) * HTB)
#define PG8_STAGE(bufoff, gbase, voff) do { _Pragma("unroll") for (int _i = 0; _i < 2; ++_i) \
        __builtin_amdgcn_global_load_lds((const unsigned*)((const char*)(gbase) + (voff)[_i]), (LAS unsigned*)(lds + (bufoff) + ldsw + _i * 8192), 16, 0, 0); } while (0)
#define PG8_LDA(dst, b, h) do { _Pragma("unroll") for (int m = 0; m < 4; ++m) _Pragma("unroll") for (int k = 0; k < 2; ++k) dst[m][k] = *(const LAS bf16x8*)(lds + PG8_SA(b, h) + aoff + m * 2048 + k * 1024); } while (0)
#define PG8_LDB(dst, b, h) do { _Pragma("unroll") for (int n = 0; n < 2; ++n) _Pragma("unroll") for (int k = 0; k < 2; ++k) dst[n][k] = *(const LAS bf16x8*)(lds + PG8_SB(b, h) + boff + n * 2048 + k * 1024); } while (0)
#define PG8_CAT(x) __builtin_shufflevector(__builtin_bit_cast(i32x4_, (x)[0]), __builtin_bit_cast(i32x4_, (x)[1]), 0, 1, 2, 3, 4, 5, 6, 7)
#define PG8_MMA(ai, bj, At, Bt) do { __builtin_amdgcn_s_setprio(1); _Pragma("unroll") for (int m = 0; m < 4; ++m) _Pragma("unroll") for (int n = 0; n < 2; ++n) { \
        if constexpr (FP8) { const i32x8 a8_ = PG8_CAT(Bt[n]), b8_ = PG8_CAT(At[m]); asm volatile("v_mfma_f32_16x16x128_f8f6f4 %0, %1, %2, %0" : "+v"(acc[ai][bj][m][n]) : "v"(a8_), "v"(b8_)); } \
        else { _Pragma("unroll") for (int k = 0; k < 2; ++k) acc[ai][bj][m][n] = __builtin_amdgcn_mfma_f32_16x16x32_bf16(Bt[n][k], At[m][k], acc[ai][bj][m][n], 0, 0, 0); } } \
        __builtin_amdgcn_s_setprio(0); } while (0)
#define PG8_WAIT_V(n) asm volatile("s_waitcnt vmcnt(" #n ")" ::: "memory")
#define PG8_WAIT_L(n) asm volatile("s_waitcnt lgkmcnt(" #n ")" ::: "memory")
#define PG8_BAR __builtin_amdgcn_s_barrier()
#define PG8_SCHED __builtin_amdgcn_sched_barrier(0)
    Unit cur, nxt; int ui = 0;
    if (!S.next(0, cur)) return;
    LAS int* idxl = (LAS int*)(lds + IDX_OFF);
    unsigned vA[2][2], vN[2][2];
    if constexpr (AGATHER) {
        Unit uu;
        {
            int av[18]; unsigned okm = 0u;
#pragma unroll
            for (int i = 0; i < 18; ++i) { const bool ok = S.next(i, uu); av[i] = (ok && tid < 256) ? g.arows[uu.am * 256 + tid] : 0; okm |= ok ? (1u << i) : 0u; }
#pragma unroll
            for (int i = 0; i < 18; ++i) if (((okm >> i) & 1u) && tid < 256) idxl[i * 256 + tid] = av[i];
            if (okm >> 17) for (int i = 18; S.next(i, uu); ++i) if (tid < 256) idxl[i * 256 + tid] = g.arows[uu.am * 256 + tid];
        }
        __syncthreads();
#pragma unroll
        for (int h = 0; h < 2; ++h)
#pragma unroll
            for (int i = 0; i < 2; ++i) vA[h][i] = (unsigned)(idxl[h * 128 + gR[i]] * g.lda + gC[i]);
    } else {
#pragma unroll
        for (int h = 0; h < 2; ++h)
#pragma unroll
            for (int i = 0; i < 2; ++i) { vA[h][i] = voffA[i]; vN[h][i] = voffA[i]; }
    }
    f32x4 acc[2][2][4][2];
#pragma unroll
    for (int a = 0; a < 2; ++a)
#pragma unroll
        for (int b = 0; b < 2; ++b)
#pragma unroll
            for (int m = 0; m < 4; ++m)
#pragma unroll
                for (int n = 0; n < 2; ++n) acc[a][b][m][n] = (f32x4){0.f, 0.f, 0.f, 0.f};
    bf16x8 At[4][2], B0[2][2], B1[2][2];
    const char* cA = (const char*)g.A + (size_t)cur.am * tstepA + cur.kofs; const char* cB = (const char*)g.Bt + (size_t)cur.bn * tstepB + cur.kofs;
    if constexpr (SP2) {
    PG8_STAGE(PG8_SB(0, 0), cB, voffB); PG8_STAGE(PG8_SB(0, 1), cB + hstepB, voffB); PG8_STAGE(PG8_SA(0, 0), cA, vA[0]); PG8_STAGE(PG8_SA(0, 1), cA + hstepA, vA[1]);
    if (wr == 1) PG8_BAR;
    PG8_WAIT_V(2); PG8_BAR;
    PG8_STAGE(PG8_SB(1, 0), cB + kstep, voffB); PG8_STAGE(PG8_SA(1, 0), cA + kstep, vA[0]); PG8_STAGE(PG8_SB(1, 1), cB + hstepB + kstep, voffB);
    PG8_WAIT_V(6); PG8_BAR;
    } else {
    PG8_STAGE(PG8_SB(0, 0), cB, voffB); PG8_STAGE(PG8_SA(0, 0), cA, vA[0]); PG8_STAGE(PG8_SB(0, 1), cB + hstepB, voffB); PG8_STAGE(PG8_SA(0, 1), cA + hstepA, vA[1]);
    if (wr == 1) PG8_BAR;
    PG8_WAIT_V(4); PG8_BAR;
    PG8_STAGE(PG8_SB(1, 0), cB + kstep, voffB); PG8_STAGE(PG8_SA(1, 0), cA + kstep, vA[0]); PG8_STAGE(PG8_SB(1, 1), cB + hstepB + kstep, voffB);
    PG8_WAIT_V(6); PG8_BAR;
    }
    for (;;) {
        const bool has_next = S.next(ui + 1, nxt);
        if constexpr (AGATHER) { const int un = has_next ? ui + 1 : ui;
#pragma unroll
            for (int h = 0; h < 2; ++h)
#pragma unroll
                for (int i = 0; i < 2; ++i) vN[h][i] = (unsigned)(idxl[un * 256 + h * 128 + gR[i]] * g.lda + gC[i]); }
        const char* nA = has_next ? (const char*)g.A + (size_t)nxt.am * tstepA + nxt.kofs : cA; const char* nB = has_next ? (const char*)g.Bt + (size_t)nxt.bn * tstepB + nxt.kofs : cB;
        for (int t = 0; t < nt; t += 2) {
            const bool last = (t == nt - 2);
            const char* a1 = cA + (size_t)(t + 1) * kstep;
            const char* a2 = last ? nA : cA + (size_t)(t + 2) * kstep; const char* b2 = last ? nB : cB + (size_t)(t + 2) * kstep;
            const char* a3 = a2 + kstep; const char* b3 = b2 + kstep;
            unsigned w0[2], w1[2];
#pragma unroll
            for (int i = 0; i < 2; ++i) { w0[i] = last ? vN[0][i] : vA[0][i]; w1[i] = last ? vN[1][i] : vA[1][i]; }
            if constexpr (SP2) {
            PG8_LDB(B0, 0, 0); PG8_LDB(B1, 0, 1); PG8_SCHED; PG8_LDA(At, 0, 0); PG8_STAGE(PG8_SA(1, 1), a1 + hstepA, vA[1]);
            PG8_WAIT_V(8); PG8_WAIT_L(0); PG8_BAR; PG8_MMA(0, 0, At, B0); PG8_MMA(0, 1, At, B1); PG8_BAR; PG8_SCHED;
            PG8_LDA(At, 0, 1); PG8_STAGE(PG8_SB(0, 0), b2, voffB); PG8_STAGE(PG8_SB(0, 1), b2 + hstepB, voffB); PG8_STAGE(PG8_SA(0, 0), a2, w0);
            PG8_WAIT_V(8); PG8_WAIT_L(0); PG8_BAR; PG8_MMA(1, 0, At, B0); PG8_MMA(1, 1, At, B1); PG8_BAR; PG8_SCHED;
            PG8_LDB(B0, 1, 0); PG8_LDB(B1, 1, 1); PG8_SCHED; PG8_LDA(At, 1, 0); PG8_STAGE(PG8_SA(0, 1), a2 + hstepA, w1);
            PG8_WAIT_V(8); PG8_WAIT_L(0); PG8_BAR; PG8_MMA(0, 0, At, B0); PG8_MMA(0, 1, At, B1); PG8_BAR; PG8_SCHED;
            PG8_LDA(At, 1, 1); PG8_STAGE(PG8_SB(1, 0), b3, voffB); PG8_STAGE(PG8_SB(1, 1), b3 + hstepB, voffB); PG8_STAGE(PG8_SA(1, 0), a3, w0);
            PG8_WAIT_V(8); PG8_WAIT_L(0); PG8_BAR; PG8_MMA(1, 0, At, B0); PG8_MMA(1, 1, At, B1); PG8_BAR; PG8_SCHED;
            } else {
            PG8_LDB(B0, 0, 0); PG8_SCHED; PG8_LDA(At, 0, 0); PG8_STAGE(PG8_SA(1, 1), a1 + hstepA, vA[1]);
            PG8_WAIT_L(8); PG8_BAR; PG8_WAIT_L(0); PG8_MMA(0, 0, At, B0); PG8_BAR; PG8_SCHED;
            PG8_LDB(B1, 0, 1); PG8_STAGE(PG8_SB(0, 0), b2, voffB);
            PG8_BAR; PG8_WAIT_L(0); PG8_MMA(0, 1, At, B1); PG8_BAR;
            PG8_LDA(At, 0, 1); PG8_STAGE(PG8_SA(0, 0), a2, w0);
            PG8_BAR; PG8_WAIT_L(0); PG8_MMA(1, 0, At, B0); PG8_BAR; PG8_SCHED;
            PG8_STAGE(PG8_SB(0, 1), b2 + hstepB, voffB);
            PG8_WAIT_V(6); PG8_BAR; PG8_MMA(1, 1, At, B1); PG8_BAR;
            PG8_LDB(B0, 1, 0); PG8_SCHED; PG8_LDA(At, 1, 0); PG8_STAGE(PG8_SA(0, 1), a2 + hstepA, w1);
            PG8_WAIT_L(8); PG8_BAR; PG8_WAIT_L(0); PG8_MMA(0, 0, At, B0); PG8_BAR; PG8_SCHED;
            PG8_LDB(B1, 1, 1); PG8_STAGE(PG8_SB(1, 0), b3, voffB);
            PG8_BAR; PG8_WAIT_L(0); PG8_MMA(0, 1, At, B1); PG8_BAR;
            PG8_LDA(At, 1, 1); PG8_STAGE(PG8_SA(1, 0), a3, w0);
            PG8_BAR; PG8_WAIT_L(0); PG8_MMA(1, 0, At, B0); PG8_BAR; PG8_SCHED;
            PG8_STAGE(PG8_SB(1, 1), b3 + hstepB, voffB);
            PG8_WAIT_V(6); PG8_BAR; PG8_MMA(1, 1, At, B1); PG8_BAR;
            }
        }
        if constexpr (ALIGN_EPI) { if (wr == 0) PG8_BAR; }
        if constexpr (FP8) asm volatile("s_nop 15\n\ts_nop 15" ::: "memory");
        else asm volatile("s_nop 15" ::: "memory");
        E(acc, cur, wr, wc, fr, fq);
        if (!has_next) break;
#pragma unroll
        for (int a = 0; a < 2; ++a)
#pragma unroll
            for (int b = 0; b < 2; ++b)
#pragma unroll
                for (int m = 0; m < 4; ++m)
#pragma unroll
                    for (int n = 0; n < 2; ++n) acc[a][b][m][n] = (f32x4){0.f, 0.f, 0.f, 0.f};
        cur = nxt; cA = nA; cB = nB; ++ui;
#pragma unroll
        for (int h = 0; h < 2; ++h)
#pragma unroll
            for (int i = 0; i < 2; ++i) vA[h][i] = vN[h][i];
        if constexpr (ALIGN_EPI) { if (wr == 1) PG8_BAR; }
    }
    PG8_WAIT_V(0);
    if constexpr (!ALIGN_EPI) { if (wr == 0) PG8_BAR; }
    PG8_BAR;
#undef PG8_SA
#undef PG8_SB
#undef PG8_STAGE
#undef PG8_LDA
#undef PG8_LDB
#undef PG8_MMA
#undef PG8_CAT
#undef PG8_WAIT_V
#undef PG8_WAIT_L
#undef PG8_BAR
#undef PG8_SCHED
}

struct RectSched {
    int nM, nN, nwg, G, c, nextra, extra_pm0, extra_pn0, extra_nn;
    int pn_split, pn_shift;
    int skew_full, skew_c0;
    __device__ void init(int nM_, int nN_, int G_, int c_) { nM = nM_; nN = nN_; nwg = nM * nN; G = G_; c = c_; nextra = 0; extra_pm0 = extra_pn0 = 0; extra_nn = 1; pn_split = 1 << 20; pn_shift = 0; skew_full = 1 << 20; skew_c0 = 0; }
    __device__ bool next(int i, Unit& u) const {
        long L;
        if (i < skew_full) L = (long)i * G + c; else { if (c < skew_c0) return false; L = (long)skew_full * G + (long)(i - skew_full) * (G - skew_c0) + (c - skew_c0); }
        if (L >= nwg + nextra) return false;
        if (L >= nwg) { const int j = (int)L - nwg; u.pm = extra_pm0 + j / extra_nn; u.pn = extra_pn0 + j % extra_nn; u.am = u.pm; u.bn = u.pn; u.kofs = 0; return true; }
        int wgid = (int)L; { const int q = nwg / 8, r = nwg % 8, xcd = wgid % 8, off = wgid / 8; wgid = (xcd < r ? xcd * (q + 1) : r * (q + 1) + (xcd - r) * q) + off; }
        const int nig = 8 * nN, gid = wgid / nig, fm = gid * 8, gsz = (nM - fm) < 8 ? (nM - fm) : 8;
        u.pm = fm + ((wgid % nig) % gsz); u.pn = (wgid % nig) / gsz; if (u.pn >= pn_split) u.pn += pn_shift; u.am = u.pm; u.bn = u.pn; u.kofs = 0; return true;
    }
};
struct ExpertSched {
    int pe, te, G, c;
    __device__ bool next(int i, Unit& u) const {
        const int cv = (G & 7) == 0 ? (c & 7) * (G >> 3) + (c >> 3) : c;
        const long L = (long)i * G + cv; const int per = pe * te; if (L >= (long)NE * per) return false;
        const int e = (int)L / per, r = (int)L % per, pn_l = r / pe, pm_l = r % pe;
        u.pm = e * PPE + pm_l; u.pn = e * te + pn_l; u.am = u.pm; u.bn = u.pn; u.kofs = 0; return true;
    }
};
struct BranchSched {
    int nM, G, c;
    __device__ bool next(int it, Unit& u) const {
        const int cv = (G & 7) == 0 ? (c & 7) * (G >> 3) + (c >> 3) : c;
        const long L = (long)it * G + cv; if (L >= (long)nM * 32) return false;
        const int blk = (int)L >> 5, w = (int)L & 31, ng = nM >> 3;
        const int i = blk / (2 * ng), pm = ((blk >> 1) % ng) * 8 + (w & 7), pn = (blk & 1) * 4 + (w >> 3);
        u.pm = pm; u.pn = i * 8 + pn; u.am = pm; u.bn = pn; u.kofs = i * 512 * 2; return true;
    }
};
struct TSched {
    int G, c;
    __device__ bool next(int it, Unit& u) const {
        const long L = (long)it * G + c; if (L >= NB * 16 * 4) return false;
        const int pn = (int)L & 3, bg = (int)L >> 2, b = bg >> 4, gq = bg & 15;
        u.pm = bg; u.pn = pn; u.am = b * 1024 + gq; u.bn = 14 + pn; u.kofs = 0; return true;
    }
};
struct FourierCtxSched {
    int G, c;
    __device__ bool next(int i, Unit& u) const {
        const long L = (long)i * G + (c + G - G / 2) % G; if (L >= 16) return false;
        const int b = (int)L >> 1, pn = (int)L & 1;
        u.pm = ML / 256 + b; u.pn = pn; u.am = 0; u.bn = b * 2 + pn; u.kofs = 0; return true;
    }
};
}
using pg8::Unit;

#define EPI_LOOP_AM _Pragma("unroll") for (int ai = 0; ai < 2; ++ai) _Pragma("unroll") for (int m = 0; m < 4; ++m)
__device__ __forceinline__ u32x4 pack8(const f32x4& v0, const f32x4& v1) { u32x4 w; w.x = cvt_pk(v0[0], v0[1]); w.y = cvt_pk(v0[2], v0[3]); w.z = cvt_pk(v1[0], v1[1]); w.w = cvt_pk(v1[2], v1[3]); return w; }

struct EpiWin {
    static constexpr bool PERM = true, SEG = false;
    bf16 *P, *GB, *Q, *KB, *ZP, *VT, *VTC, *TT, *TTC; const float *qnw, *knw;
    __device__ __forceinline__ void operator()(const f32x4 (&acc)[2][2][4][2], const Unit& u, int wr, int wc, int fr, int fq) const {
        const int pn = u.pn; const int rowb = u.pm * 256 + wr * 64 + fr; const int cl8 = wc * 32 + 8 * fq;
        const bool isctx = u.pm >= ML / 256;
        if (pn < 4) {
            EPI_LOOP_AM { const size_t row = rowb + ai * 128 + m * 16; const f32x4 v0 = acc[ai][0][m][0] * acc[ai][1][m][0], v1 = acc[ai][0][m][1] * acc[ai][1][m][1];
                *(u32x4*)(P + row * 512 + 128 * pn + cl8) = pack8(v0, v1); }
        } else if (pn < 6 || pn == 12 || pn == 13) {
            bf16* O = pn < 6 ? GB : ZP; const int c0 = 256 * (pn < 6 ? pn - 4 : pn - 12) + cl8;
            EPI_LOOP_AM { const size_t row = rowb + ai * 128 + m * 16;
#pragma unroll
                for (int bj = 0; bj < 2; ++bj) *(u32x4*)(O + row * 512 + c0 + 128 * bj) = pack8(acc[ai][bj][m][0], acc[ai][bj][m][1]); }
        } else if (pn < 10) {
            const bool isq = pn < 8; const float* nw = isq ? qnw : knw; bf16* O = isq ? Q : KB; const int head = 4 * (pn & 1) + wc; const float osc = isq ? 0.125f * LOG2E : 1.0f;
            f32x4 w[2][2];
#pragma unroll
            for (int bj = 0; bj < 2; ++bj)
#pragma unroll
                for (int n = 0; n < 2; ++n) w[bj][n] = *(const f32x4*)(nw + 32 * bj + 8 * fq + 4 * n) * osc;
            EPI_LOOP_AM { const size_t row = rowb + ai * 128 + m * 16; float ss = 0.f;
#pragma unroll
                for (int bj = 0; bj < 2; ++bj)
#pragma unroll
                    for (int n = 0; n < 2; ++n) { const f32x4 x = acc[ai][bj][m][n]; ss += (x[0] * x[0] + x[1] * x[1]) + (x[2] * x[2] + x[3] * x[3]); }
                ss += shx(ss, 16); ss += shx(ss, 32);
                const float rs = __builtin_amdgcn_rsqf(ss * (1.0f / 64.0f) + EPS);
#pragma unroll
                for (int bj = 0; bj < 2; ++bj) *(u32x4*)(O + row * 512 + 64 * head + 32 * bj + 8 * fq) = pack8(acc[ai][bj][m][0] * rs * w[bj][0], acc[ai][bj][m][1] * rs * w[bj][1]); }
        } else if (pn < 12) {
            const int head = 4 * (pn & 1) + wc; const int b = isctx ? (u.pm - ML / 256) : (u.pm >> 4);
            bf16* O = isctx ? VTC + (size_t)(b * NH + head) * HD * LC : VT + (size_t)(b * NH + head) * HD * SEQ; const int npitch = isctx ? LC : SEQ;
            const int tokb = isctx ? (wr * 64 + fr) : ((u.pm & 15) * 256 + wr * 64 + fr);
            EPI_LOOP_AM { const int tok = tokb + ai * 128 + m * 16;
#pragma unroll
                for (int bj = 0; bj < 2; ++bj)
#pragma unroll
                    for (int n = 0; n < 2; ++n)
#pragma unroll
                        for (int j = 0; j < 4; ++j) O[(size_t)(32 * bj + 8 * fq + 4 * n + j) * npitch + tok] = f2bf(acc[ai][bj][m][n][j]); }
        } else if (pn < 18) {
            const int b = isctx ? (u.pm - ML / 256) : (u.pm >> 4); const int npitch = isctx ? LC : SEQ;
            bf16* O = isctx ? TTC + (size_t)b * 512 * 2 * LC : TT + (size_t)b * 512 * 2 * SEQ;
            const int tokb = isctx ? (wr * 64 + fr) : ((u.pm & 15) * 256 + wr * 64 + fr);
            EPI_LOOP_AM { const int tok = tokb + ai * 128 + m * 16;
#pragma unroll
                for (int bj = 0; bj < 2; ++bj)
#pragma unroll
                    for (int n = 0; n < 2; ++n)
#pragma unroll
                        for (int j = 0; j < 4; ++j) { const int uu = 256 * (pn - 14) + 128 * bj + cl8 + 4 * n + j; const int part = uu >> 9, cp = uu & 511;
                            O[((size_t)cp * 2 + part) * npitch + tok] = f2bf(acc[ai][bj][m][n][j]); } }
        }
    }
};
struct EpiQKV8 {
    static constexpr bool PERM = true, SEG = false;
    bf16 *Q, *KB, *VT, *VTC; const float *qnw, *knw; LAS unsigned char* xl;
    __device__ __forceinline__ void operator()(const f32x4 (&acc)[2][2][4][2], const Unit& u, int wr, int wc, int fr, int fq) const {
        const int pn = u.pn + 6; const int rowb = u.pm * 256 + wr * 64 + fr; const bool isctx = u.pm >= ML / 256; constexpr float is = 1.0f / W8SCALE;
        if (pn < 10) {
            const bool isq = pn < 8; const float* nw = isq ? qnw : knw; bf16* O = isq ? Q : KB; const int head = 4 * (pn & 1) + wc; const float osc = isq ? 0.125f * LOG2E : 1.0f;
            f32x4 w[2][2];
#pragma unroll
            for (int bj = 0; bj < 2; ++bj)
#pragma unroll
                for (int n = 0; n < 2; ++n) w[bj][n] = *(const f32x4*)(nw + 32 * bj + 8 * fq + 4 * n) * (osc * is);
            EPI_LOOP_AM { const size_t row = rowb + ai * 128 + m * 16; float ss = 0.f;
#pragma unroll
                for (int bj = 0; bj < 2; ++bj)
#pragma unroll
                    for (int n = 0; n < 2; ++n) { const f32x4 x = acc[ai][bj][m][n] * is; ss += (x[0] * x[0] + x[1] * x[1]) + (x[2] * x[2] + x[3] * x[3]); }
                ss += shx(ss, 16); ss += shx(ss, 32);
                const float rs = __builtin_amdgcn_rsqf(ss * (1.0f / 64.0f) + EPS);
#pragma unroll
                for (int bj = 0; bj < 2; ++bj) *(u32x4*)(O + row * 512 + 64 * head + 32 * bj + 8 * fq) = pack8(acc[ai][bj][m][0] * rs * w[bj][0], acc[ai][bj][m][1] * rs * w[bj][1]); }
        } else {
            const int head = 4 * (pn & 1) + wc; const int b = isctx ? (u.pm - ML / 256) : (u.pm >> 4);
            bf16* O = isctx ? VTC + (size_t)(b * NH + head) * HD * LC : VT + (size_t)(b * NH + head) * HD * SEQ; const int npitch = isctx ? LC : SEQ;
            const int tok0 = isctx ? (wr * 64) : ((u.pm & 15) * 256 + wr * 64); const int ln = fr + 16 * fq, dr = ln & 31, hf = ln >> 5;
            LAS unsigned char* xw = xl + (wr * 4 + wc) * 2304;
            EPI_LOOP_AM {
#pragma unroll
                for (int bj = 0; bj < 2; ++bj) {
#pragma unroll
                    for (int n = 0; n < 2; ++n)
#pragma unroll
                        for (int j = 0; j < 4; ++j) { const int dl = 8 * fq + 4 * n + j; *(LAS bf16*)(xw + 32 * (dl + fq) + 2 * fr) = f2bf(acc[ai][bj][m][n][j] * is); }
                    asm volatile("" ::: "memory");
                    const u32x4 r = *(const LAS u32x4*)(xw + 32 * (dr + (dr >> 3)) + 16 * hf);
                    asm volatile("" ::: "memory");
                    *(u32x4*)(O + (size_t)(32 * bj + dr) * npitch + tok0 + ai * 128 + m * 16 + 8 * hf) = r; } }
        }
    }
};
struct EpiWinT {
    static constexpr bool PERM = true, SEG = false;
    bf16* TT; LAS unsigned char* xl;
    __device__ __forceinline__ void operator()(const f32x4 (&acc)[2][2][4][2], const Unit& u, int wr, int wc, int fr, int fq) const {
        const int b = u.pm >> 4, gq = u.pm & 15; bf16* O = TT + (size_t)b * 512 * 2 * SEQ;
        LAS unsigned char* xw = xl + (wr * 4 + wc) * 2304;
        const int ln = fr + 16 * fq, fqr = ln >> 4, jr = (ln >> 2) & 3, n2r = ln & 3;
#pragma unroll
        for (int ai = 0; ai < 2; ++ai)
#pragma unroll
            for (int bj = 0; bj < 2; ++bj)
#pragma unroll
                for (int n = 0; n < 2; ++n) {
#pragma unroll
                    for (int m = 0; m < 4; ++m)
#pragma unroll
                        for (int j = 0; j < 4; ++j) *(LAS bf16*)(xw + 32 * (16 * fq + 4 * j + (fr & 3)) + 8 * fq + 2 * (4 * m + (fr >> 2))) = f2bf(acc[ai][bj][m][n][j]);
                    asm volatile("" ::: "memory");
                    const LAS unsigned char* rp = xw + 32 * ln + 8 * fqr;
                    const u32x2 r0 = *(const LAS u32x2*)(rp), r1 = *(const LAS u32x2*)(rp + 8), r2 = *(const LAS u32x2*)(rp + 16), r3 = *(const LAS u32x2*)(rp + 24);
                    asm volatile("" ::: "memory");
                    const int uu = 256 * u.pn + 128 * bj + 32 * wc + 8 * fqr + 4 * n + jr; const int part = uu >> 9, cp = uu & 511;
                    bf16* op = O + (((size_t)cp * 64 + 4 * gq + n2r) * 2 + part) * 64 + 32 * ai + 16 * wr;
                    u32x4 w0, w1; w0.x = r0.x; w0.y = r0.y; w0.z = r1.x; w0.w = r1.y; w1.x = r2.x; w1.y = r2.y; w1.z = r3.x; w1.w = r3.y;
                    *(u32x4*)op = w0; *(u32x4*)(op + 8) = w1; }
    }
};
struct EpiPlain {
    static constexpr bool PERM = true, SEG = false;
    bf16* O; int ldc; int col0;
    __device__ __forceinline__ void operator()(const f32x4 (&acc)[2][2][4][2], const Unit& u, int wr, int wc, int fr, int fq) const {
        const int rowb = u.pm * 256 + wr * 64 + fr; const int c0 = col0 + 256 * u.pn + wc * 32 + 8 * fq;
        EPI_LOOP_AM { const size_t row = rowb + ai * 128 + m * 16;
#pragma unroll
            for (int bj = 0; bj < 2; ++bj) *(u32x4*)(O + row * ldc + c0 + 128 * bj) = pack8(acc[ai][bj][m][0], acc[ai][bj][m][1]); }
    }
};
struct EpiY {
    static constexpr bool PERM = true, SEG = false;
    bf16* O;
    __device__ __forceinline__ void operator()(const f32x4 (&acc)[2][2][4][2], const Unit& u, int wr, int wc, int fr, int fq) const {
        const int rowb = u.pm * 256 + wr * 64 + fr; const int c0 = 256 * (u.pn & 7) + wc * 32 + 8 * fq;
        EPI_LOOP_AM { const size_t row = rowb + ai * 128 + m * 16;
#pragma unroll
            for (int bj = 0; bj < 2; ++bj) *(u32x4*)(O + row * D + c0 + 128 * bj) = pack8(acc[ai][bj][m][0] * (1.0f / W8SCALE), acc[ai][bj][m][1] * (1.0f / W8SCALE)); }
    }
};
struct EpiGate {
    static constexpr bool PERM = true, SEG = false;
    const bf16* PB; bf16* MG;
    __device__ __forceinline__ void operator()(const f32x4 (&acc)[2][2][4][2], const Unit& u, int wr, int wc, int fr, int fq) const {
        const int rowb = u.pm * 256 + wr * 64 + fr; const int odd = fq & 1; const int colp = 64 * u.pn + 16 * wc + 4 * (fq & 2);
#pragma unroll
        for (int ai = 0; ai < 2; ++ai) {
            u32x4 tq[4][2];
#pragma unroll
            for (int m = 0; m < 4; ++m)
#pragma unroll
                for (int pp = 0; pp < 2; ++pp) tq[m][pp] = *(const u32x4*)(PB + (size_t)(rowb + ai * 128 + m * 16) * 8192 + colp + odd * 2048 + pp * 4096);
            asm volatile("" ::: "memory");
#pragma unroll
            for (int mp = 0; mp < 2; ++mp) {
                u32x2 wv[2];
#pragma unroll
                for (int mm = 0; mm < 2; ++mm) { const int m = 2 * mp + mm;
                    u32x2 pv[4];
#pragma unroll
                    for (int pp = 0; pp < 2; ++pp) { const u32x4 t = tq[m][pp];
                        const auto s0 = __builtin_amdgcn_permlane16_swap(t.x, t.z, false, false), s1 = __builtin_amdgcn_permlane16_swap(t.y, t.w, false, false);
                        pv[2 * pp].x = s0[0]; pv[2 * pp].y = s1[0]; pv[2 * pp + 1].x = s0[1]; pv[2 * pp + 1].y = s1[1]; }
                    f32x4 o = (f32x4){0.f, 0.f, 0.f, 0.f};
#pragma unroll
                    for (int bj = 0; bj < 2; ++bj)
#pragma unroll
                        for (int n = 0; n < 2; ++n) { const u32x2 pq = pv[2 * bj + n]; const f32x4 g = acc[ai][bj][m][n] * (1.0f / W8SCALE);
                            o[0] += sigmoidf_(g[0]) * bflo(pq.x); o[1] += sigmoidf_(g[1]) * bfhi(pq.x); o[2] += sigmoidf_(g[2]) * bflo(pq.y); o[3] += sigmoidf_(g[3]) * bfhi(pq.y); }
                    wv[mm].x = cvt_pk(o[0], o[1]); wv[mm].y = cvt_pk(o[2], o[3]); }
                const auto s0 = __builtin_amdgcn_permlane16_swap(wv[0].x, wv[1].x, false, false), s1 = __builtin_amdgcn_permlane16_swap(wv[0].y, wv[1].y, false, false);
                u32x4 w; w.x = s0[0]; w.y = s1[0]; w.z = s0[1]; w.w = s1[1];
                *(u32x4*)(MG + (size_t)(rowb + ai * 128 + (2 * mp + odd) * 16) * D + colp) = w; }
        }
    }
};
struct EpiWout {
    static constexpr bool PERM = false, SEG = false;
    const float *xin_l, *xin_c; float *xout_l, *xout_c; const float* modl; const float* bada;
    __device__ __forceinline__ void operator()(const f32x4 (&acc)[2][2][4][2], const Unit& u, int wr, int wc, int fr, int fq) const {
        const bool isctx = u.pm >= ML / 256; const int s = isctx ? 8 : (u.pm >> 4);
        const float* xi = isctx ? xin_c - (size_t)ML * D : xin_l; float* xo = isctx ? xout_c - (size_t)ML * D : xout_l;
        const int rowb = u.pm * 256 + wr * 64 + fr; const int c0 = 256 * u.pn + wc * 32 + 4 * fq;
        f32x4 gv[2][2];
#pragma unroll
        for (int bj = 0; bj < 2; ++bj)
#pragma unroll
            for (int n = 0; n < 2; ++n) { const int c = c0 + 128 * bj + 16 * n; gv[bj][n] = *(const f32x4*)(modl + (size_t)s * 6 * D + 2 * D + c) + *(const f32x4*)(bada + 2 * D + c); }
#pragma unroll
        for (int ai = 0; ai < 2; ++ai) {
            f32x4 xr[4][2][2];
#pragma unroll
            for (int m = 0; m < 4; ++m)
#pragma unroll
                for (int bj = 0; bj < 2; ++bj)
#pragma unroll
                    for (int n = 0; n < 2; ++n) xr[m][bj][n] = *(const f32x4*)(xi + (size_t)(rowb + ai * 128 + m * 16) * D + c0 + 128 * bj + 16 * n);
            asm volatile("" ::: "memory");
#pragma unroll
            for (int m = 0; m < 4; ++m)
#pragma unroll
                for (int bj = 0; bj < 2; ++bj)
#pragma unroll
                    for (int n = 0; n < 2; ++n) *(f32x4*)(xo + (size_t)(rowb + ai * 128 + m * 16) * D + c0 + 128 * bj + 16 * n) = xr[m][bj][n] + gv[bj][n] * acc[ai][bj][m][n];
            asm volatile("" ::: "memory");
        }
    }
};
struct EpiGU {
    static constexpr bool PERM = true, SEG = false;
    unsigned char* HID;
    __device__ __forceinline__ void operator()(const f32x4 (&acc)[2][2][4][2], const Unit& u, int wr, int wc, int fr, int fq) const {
        const int rowb = u.pm * 256 + wr * 64 + fr; const int c0 = 128 * (u.pn & 15) + wc * 32 + 8 * fq;
        constexpr float is = 1.0f / W8SCALE;
        EPI_LOOP_AM { const size_t row = rowb + ai * 128 + m * 16; f32x4 v0, v1;
#pragma unroll
            for (int j = 0; j < 4; ++j) { v0[j] = siluf_(acc[ai][0][m][0][j] * is) * (acc[ai][1][m][0][j] * is); v1[j] = siluf_(acc[ai][0][m][1][j] * is) * (acc[ai][1][m][1][j] * is); }
            u32x2 w; w.x = cvt4_fp8(v0[0], v0[1], v0[2], v0[3]); w.y = cvt4_fp8(v1[0], v1[1], v1[2], v1[3]);
            *(u32x2*)(HID + row * FF + c0) = w; }
    }
};

struct Args {
    const float *x, *c, *ctx, *c_ctx, *w_ada, *b_ada, *norm1_w, *norm2_w, *w_in, *conv_w, *q_norm_w, *k_norm_w, *na_rpb, *pool_w, *pool_scale, *w_branch, *w_out, *w_router, *w_exp_gate, *w_exp_up, *w_exp_down;
    float* out; unsigned char* ws; int ph_lo, ph_hi;
};
struct Frame { LAS unsigned char* lds; int tid, lane, wave, G, c; };
#define GPTR(T, v) ((T*)(__attribute__((address_space(1))) T*)(v))
__device__ __forceinline__ Args load_args() {
    typedef const unsigned long long __attribute__((address_space(4))) * KW;
    KW p = (KW)__builtin_amdgcn_kernarg_segment_ptr(); asm volatile("" : "+s"(p));
    Args r;
    r.x = GPTR(const float, p[0]);
    r.c = GPTR(const float, p[1]);
    r.ctx = GPTR(const float, p[2]);
    r.c_ctx = GPTR(const float, p[3]);
    r.w_ada = GPTR(const float, p[4]);
    r.b_ada = GPTR(const float, p[5]);
    r.norm1_w = GPTR(const float, p[6]);
    r.norm2_w = GPTR(const float, p[7]);
    r.w_in = GPTR(const float, p[8]);
    r.conv_w = GPTR(const float, p[9]);
    r.q_norm_w = GPTR(const float, p[10]);
    r.k_norm_w = GPTR(const float, p[11]);
    r.na_rpb = GPTR(const float, p[12]);
    r.pool_w = GPTR(const float, p[13]);
    r.pool_scale = GPTR(const float, p[14]);
    r.w_branch = GPTR(const float, p[15]);
    r.w_out = GPTR(const float, p[16]);
    r.w_router = GPTR(const float, p[17]);
    r.w_exp_gate = GPTR(const float, p[18]);
    r.w_exp_up = GPTR(const float, p[19]);
    r.w_exp_down = GPTR(const float, p[20]);
    r.out = GPTR(float, p[21]); r.ws = GPTR(unsigned char, p[22]); r.ph_lo = 0; r.ph_hi = 0;
    return r;
}
#define ARGS_HERE const Args a = load_args()
__device__ __forceinline__ Frame fresh_frame(LAS unsigned char* lds, int wave) {
    Frame F; const int t = fresh_tid(wave); F.lds = lds; F.tid = t; F.lane = t & 63; F.wave = wave; F.G = gridDim.x; F.c = blockIdx.x; return F; }

__device__ __forceinline__ void tr_item_bf16(const float* srcq, size_t ldsrc, bf16* dst, size_t lddst, int g) {
    f32x4 v[8];
#pragma unroll
    for (int i = 0; i < 8; ++i) v[i] = __builtin_nontemporal_load((const f32x4*)(srcq + (size_t)(8 * g + i) * ldsrc));
#pragma unroll
    for (int e = 0; e < 4; ++e) { u32x4 o; o.x = cvt_pk(v[0][e], v[1][e]); o.y = cvt_pk(v[2][e], v[3][e]); o.z = cvt_pk(v[4][e], v[5][e]); o.w = cvt_pk(v[6][e], v[7][e]);
        *(u32x4*)(dst + (size_t)e * lddst + 8 * g) = o; }
}
__device__ __forceinline__ void tr_load_fp8(const float* srcq, size_t ldsrc, int g, f32x4 (&v)[16]) {
#pragma unroll
    for (int i = 0; i < 16; ++i) v[i] = __builtin_nontemporal_load((const f32x4*)(srcq + (size_t)(16 * g + i) * ldsrc));
}
__device__ __forceinline__ void tr_store_fp8(const f32x4 (&v)[16], unsigned char* dst, size_t lddst, int g) {
#pragma unroll
    for (int e = 0; e < 4; ++e) { u32x4 o;
        o.x = cvt4_fp8(v[0][e] * W8SCALE, v[1][e] * W8SCALE, v[2][e] * W8SCALE, v[3][e] * W8SCALE); o.y = cvt4_fp8(v[4][e] * W8SCALE, v[5][e] * W8SCALE, v[6][e] * W8SCALE, v[7][e] * W8SCALE);
        o.z = cvt4_fp8(v[8][e] * W8SCALE, v[9][e] * W8SCALE, v[10][e] * W8SCALE, v[11][e] * W8SCALE); o.w = cvt4_fp8(v[12][e] * W8SCALE, v[13][e] * W8SCALE, v[14][e] * W8SCALE, v[15][e] * W8SCALE);
        __builtin_nontemporal_store(o, (u32x4*)(dst + (size_t)e * lddst + 16 * g)); }
}
__device__ __forceinline__ void tr_item_fp8(const float* srcq, size_t ldsrc, unsigned char* dst, size_t lddst, int g) { f32x4 v[16]; tr_load_fp8(srcq, ldsrc, g, v); tr_store_fp8(v, dst, lddst, g); }
__device__ __forceinline__ int win_src_col(int Gd, int q) {
    const int pn = Gd >> 3, g8 = Gd & 7, bj = g8 >> 2, wc = g8 & 3;
    if (pn < 4) return (bj ? 1024 : 0) + 128 * pn + 32 * wc + 4 * q;
    if (pn < 6) return 512 + 256 * (pn - 4) + 32 * g8 + 4 * q;
    if (pn < 12) return 1536 + 512 * ((pn - 6) >> 1) + 64 * (4 * (pn & 1) + wc) + 32 * bj + 4 * q;
    if (pn < 14) return 3584 + 256 * (pn - 12) + 32 * g8 + 4 * q;
    if (pn < 18) return -1;
    return 4096 + (2 * bj + (q & 1)) * 2048 + 64 * (pn - 18) + 16 * wc + 4 * (q >> 1);
}
__device__ __forceinline__ void convert_weights(const Frame& F, const Args& a, int l) {
    unsigned char* ws = a.ws;
    bf16* Win_t = (bf16*)(ws + WS_WIN); bf16* Wbr_t = (bf16*)(ws + WS_WBR); bf16* Wout_t = (bf16*)(ws + WS_WOUT); unsigned char* Wgu_t = ws + WS_WGU; unsigned char* Wd_t = ws + WS_WD;
    const int gw = F.c * 8 + F.wave, NGW = F.G * 8; const int q = F.lane & 7, g = F.lane >> 3;
    const float* w_in = a.w_in + (size_t)l * D * INC; const float* w_br = a.w_branch + (size_t)l * 4 * MIXW * D; const float* w_out = a.w_out + (size_t)l * D * D;
    const float* w_g = a.w_exp_gate + (size_t)l * NE * D * FF; const float* w_u = a.w_exp_up + (size_t)l * NE * D * FF; const float* w_d = a.w_exp_down + (size_t)l * NE * FF * D;
    constexpr int I_WIN = 32 * 400, I_WBR = 3 * 8 * 64, I_WOUT = 32 * 64, I_WGU = NE * 16 * 128, I_WD = NE * 16 * 64;
    {
        constexpr int NT = NE * 3 * 16 * 8;
        const int w = F.wave, ln = F.lane;
        auto src_of = [&](int t) -> const float* { const int em = t >> 7, e = em / 3, m = em - 3 * e, kb = (t >> 3) & 15, nb = t & 7;
            const float* W = m == 0 ? w_g : (m == 1 ? w_u : w_d); return W + (size_t)e * D * FF + (size_t)(128 * kb + 16 * w) * 2048 + 256 * nb + 4 * ln; };
        f32x4 v[16];
        int t = F.c, par = 0;
        __syncthreads();
        if (t < NT) { const float* sp = src_of(t);
#pragma unroll
            for (int i = 0; i < 16; ++i) v[i] = __builtin_nontemporal_load((const f32x4*)(sp + (size_t)i * 2048)); }
#pragma unroll 1
        for (; t < NT; t += F.G) {
            f32x4 vn[16];
            if (t + F.G < NT) { const float* sp = src_of(t + F.G);
#pragma unroll
                for (int i = 0; i < 16; ++i) vn[i] = __builtin_nontemporal_load((const f32x4*)(sp + (size_t)i * 2048)); }
            LAS unsigned char* tb = F.lds + par * 32768;
#pragma unroll
            for (int e = 0; e < 4; ++e) { u32x4 o;
                o.x = cvt4_fp8(v[0][e] * W8SCALE, v[1][e] * W8SCALE, v[2][e] * W8SCALE, v[3][e] * W8SCALE); o.y = cvt4_fp8(v[4][e] * W8SCALE, v[5][e] * W8SCALE, v[6][e] * W8SCALE, v[7][e] * W8SCALE);
                o.z = cvt4_fp8(v[8][e] * W8SCALE, v[9][e] * W8SCALE, v[10][e] * W8SCALE, v[11][e] * W8SCALE); o.w = cvt4_fp8(v[12][e] * W8SCALE, v[13][e] * W8SCALE, v[14][e] * W8SCALE, v[15][e] * W8SCALE);
                *(LAS u32x4*)(tb + (4 * ln + e) * 128 + ((w ^ (ln & 7)) * 16)) = o; }
            __syncthreads();
            { const int em = t >> 7, e_ = em / 3, m = em - 3 * e_, kb = (t >> 3) & 15, nb = t & 7; unsigned char* base = m < 2 ? Wgu_t : Wd_t;
#pragma unroll
              for (int j = 0; j < 4; ++j) { const int n = 32 * w + 8 * j + (ln >> 3), c = ln & 7; const u32x4 o = *(const LAS u32x4*)(tb + n * 128 + ((c ^ ((n >> 2) & 7)) * 16));
                  const int col = 256 * nb + n; const size_t row = m < 2 ? (size_t)e_ * 2 * FF + col + 128 * (col >> 7) + 128 * m : (size_t)e_ * D + col;
                  __builtin_nontemporal_store(o, (u32x4*)(base + row * 2048 + 128 * kb + 16 * c)); } }
            par ^= 1;
#pragma unroll
            for (int i = 0; i < 16; ++i) v[i] = vn[i];
        }
        __syncthreads();
    }
    constexpr int NIT = I_WIN + I_WBR + I_WOUT;
#pragma unroll 1
    for (int it = gw; it < NIT; it += NGW) {
        int r = it;
        if (r < I_WIN) { const int kb = r / 400, Gd = r % 400; const int sc = win_src_col(Gd, q);
            if (sc >= 0 && Gd < 18 * 8 && !(Gd >= 6 * 8 && Gd < 12 * 8)) tr_item_bf16(w_in + (size_t)(64 * kb) * INC + sc, INC, Win_t + (size_t)(32 * Gd + 4 * q) * D + 64 * kb, D, g);
            continue; } r -= I_WIN;
        if (r < I_WBR) { const int i = r / 512, r2 = r % 512, kb = r2 / 64, Gd = r2 % 64; tr_item_bf16(w_br + (size_t)i * MIXW * D + (size_t)(64 * kb) * D + 32 * Gd + 4 * q, D, Wbr_t + (size_t)(32 * Gd + 4 * q) * D + 512 * i + 64 * kb, D, g); continue; } r -= I_WBR;
        { const int kb = r / 64, Gd = r % 64; tr_item_bf16(w_out + (size_t)(64 * kb) * D + 32 * Gd + 4 * q, D, Wout_t + (size_t)(32 * Gd + 4 * q) * D + 64 * kb, D, g); }
    }
#pragma unroll 1
    for (int it = gw; it < 16 * 48; it += NGW) { const int kb = it / 48, Gdp = it % 48; const int sc = win_src_col(Gdp + 6 * 8, q);
        tr_item_fp8(w_in + (size_t)(128 * kb) * INC + sc, INC, ws + WS_WQKV8 + (size_t)(32 * Gdp + 4 * q) * D + 128 * kb, D, g); }
#pragma unroll 1
    for (int it = gw; it < 16 * 256; it += NGW) { const int kb = it >> 8, Gdp = it & 255; const int sc = win_src_col(Gdp + 18 * 8, q);
        tr_item_fp8(w_in + (size_t)(128 * kb) * INC + sc, INC, ws + WS_WG8 + (size_t)(32 * Gdp + 4 * q) * D + 128 * kb, D, g); }
    __syncthreads();
    LAS float* trig = (LAS float*)F.lds;
    LAS float* wl = (LAS float*)(F.lds + 1024);
    if (F.tid < 128) { float sv, cv; sincospif((float)F.tid * (2.0f / 128.0f), &sv, &cv); trig[F.tid] = cv * 0.08838834764831845f; trig[128 + F.tid] = sv * 0.08838834764831845f; }
    const int half = F.tid >> 8, ht = F.tid & 255, part = ht >> 7, c2 = ht & 127;
#pragma unroll 1
    for (int it0 = ((F.c + F.G / 4) % F.G) * 2; it0 < 32 * 4; it0 += F.G * 2) {
        const int it = it0 + half; const int kb64 = it >> 2, gg = it & 3;
#pragma unroll 1
        for (int k8 = 0; k8 < 8; ++k8) { const int kb8 = 8 * kb64 + k8;
            __syncthreads();
            { float t4[4];
#pragma unroll
              for (int u = 0; u < 4; ++u) { const int i = ht + 256 * u; t4[u] = w_in[(size_t)(8 * kb8 + (i >> 7)) * INC + 3072 + 128 * gg + (i & 127)]; }
#pragma unroll
              for (int u = 0; u < 4; ++u) wl[half * 1024 + ht + 256 * u] = t4[u]; }
            __syncthreads();
            float acc[8];
#pragma unroll
            for (int kk = 0; kk < 8; ++kk) acc[kk] = 0.f;
#pragma unroll 4
            for (int cc = 0; cc < 128; ++cc) { const float tv = trig[part * 128 + ((cc * c2) & 127)];
#pragma unroll
                for (int kk = 0; kk < 8; ++kk) acc[kk] += wl[half * 1024 + kk * 128 + cc] * tv; }
            u32x4 o; o.x = cvt_pk(acc[0], acc[1]); o.y = cvt_pk(acc[2], acc[3]); o.z = cvt_pk(acc[4], acc[5]); o.w = cvt_pk(acc[6], acc[7]);
            *(u32x4*)(Win_t + (size_t)(14 * 256 + part * 512 + 128 * gg + c2) * D + 8 * kb8) = o; }
    }
    __syncthreads();
    const float* pw = a.pool_w + (size_t)l * 4 * 128 * 128; const float* ps = a.pool_scale + (size_t)l * MIXW; const float* wb3 = w_br + (size_t)3 * MIXW * D;
#pragma unroll 1
    for (int it = gw; it < 8 * 32 * 8; it += NGW) {
        const int gc8 = (it >> 8) * 8 + (it & 7), nb = (it >> 3) & 31, gg = gc8 >> 4; const int n = 64 * nb + F.lane;
        float acc[8];
#pragma unroll
        for (int i = 0; i < 8; ++i) acc[i] = 0.f;
        const float* pwr = pw + (size_t)(8 * gc8) * 128;
        LAS float* pl = (LAS float*)(F.lds + F.wave * 4096);
        { f32x4 t4[4];
#pragma unroll
          for (int k = 0; k < 4; ++k) t4[k] = *(const f32x4*)(pwr + (k * 64 + F.lane) * 4);
#pragma unroll
          for (int k = 0; k < 4; ++k) *(LAS f32x4*)(pl + (k * 64 + F.lane) * 4) = t4[k]; }
        asm volatile("s_waitcnt lgkmcnt(0)" ::: "memory");
#pragma unroll 1
        for (int d0 = 0; d0 < 128; d0 += 8) { float wv[8];
#pragma unroll
            for (int u8 = 0; u8 < 8; ++u8) wv[u8] = ps[128 * gg + d0 + u8] * wb3[(size_t)(128 * gg + d0 + u8) * D + n];
#pragma unroll
            for (int i = 0; i < 8; ++i) { const f32x4 p0 = *(const LAS f32x4*)(pl + i * 128 + d0), p1 = *(const LAS f32x4*)(pl + i * 128 + d0 + 4);
                acc[i] += p0[0] * wv[0]; acc[i] += p0[1] * wv[1]; acc[i] += p0[2] * wv[2]; acc[i] += p0[3] * wv[3];
                acc[i] += p1[0] * wv[4]; acc[i] += p1[1] * wv[5]; acc[i] += p1[2] * wv[6]; acc[i] += p1[3] * wv[7]; } }
        asm volatile("" ::: "memory");
        u32x4 o; o.x = cvt_pk(acc[0], acc[1]); o.y = cvt_pk(acc[2], acc[3]); o.z = cvt_pk(acc[4], acc[5]); o.w = cvt_pk(acc[6], acc[7]);
        *(u32x4*)(Wbr_t + (size_t)n * D + 1536 + 8 * gc8) = o;
    }
}
__device__ __forceinline__ void prologue_misc(const Frame& F, const Args& a) {
    float* MOD = (float*)(a.ws + WS_MOD);
    LAS float* scs = (LAS float*)F.lds;
    LAS float* part = (LAS float*)(F.lds + 9 * D * 4);
    __syncthreads();
    {
        float cv[36];
#pragma unroll
        for (int u = 0; u < 36; ++u) { const int i = F.tid + 512 * u, s = i >> 11, kk = i & 2047; cv[u] = s < 8 ? a.c[(size_t)s * D + kk] : a.c_ctx[kk]; }
#pragma unroll
        for (int u = 0; u < 36; ++u) scs[F.tid + 512 * u] = siluf_(cv[u]);
    }
    __syncthreads();
    for (int it = F.c; it < 2 * 96; it += F.G) {
        const int l = it / 96, jb = it % 96, col = F.tid & 127, kq = F.tid >> 7;
        const int j = 128 * jb + col; const float* wp = a.w_ada + ((size_t)l * D + 512 * kq) * (6 * D) + j;
        float acc[9];
#pragma unroll
        for (int s = 0; s < 9; ++s) acc[s] = 0.f;
#pragma unroll 4
        for (int kk = 0; kk < 512; ++kk) { const float w = __builtin_nontemporal_load(wp + (size_t)kk * (6 * D));
#pragma unroll
            for (int s = 0; s < 9; ++s) acc[s] += scs[s * D + 512 * kq + kk] * w; }
#pragma unroll
        for (int s = 0; s < 9; ++s) part[(kq * 9 + s) * 128 + col] = acc[s];
        __syncthreads();
        for (int i = F.tid; i < 9 * 128; i += 512) { const int s = i >> 7, cc = i & 127;
            MOD[((size_t)l * 9 + s) * (6 * D) + 128 * jb + cc] = ((part[(0 * 9 + s) * 128 + cc] + part[(1 * 9 + s) * 128 + cc]) + part[(2 * 9 + s) * 128 + cc]) + part[(3 * 9 + s) * 128 + cc]; }
        __syncthreads();
    }
    __syncthreads();
    LAS float* tab = (LAS float*)F.lds;
    for (int i = F.tid; i < 256; i += 512) { float sv, cv; sincospif((float)i * (2.0f / 256.0f), &sv, &cv); tab[2 * i] = cv; tab[2 * i + 1] = sv; }
    __syncthreads();
    bf16* DFTC = (bf16*)(a.ws + WS_DFTC);
    for (int kk = F.c; kk < LC; kk += F.G) { unsigned* row = (unsigned*)(DFTC + (size_t)kk * 2 * LC);
        for (int i = F.tid; i < LC; i += 512) { const int part = i >> 7, n = (i & 127) * 2; const int m0 = (kk * n) & 255, m1 = (kk * (n + 1)) & 255;
            const float v0 = part ? -tab[2 * m0 + 1] : tab[2 * m0], v1 = part ? -tab[2 * m1 + 1] : tab[2 * m1]; row[i] = cvt_pk(v0 * (1.0f / 16.0f), v1 * (1.0f / 16.0f)); } }
    __syncthreads();
}

template <int MODE>
__device__ __forceinline__ void norm_phase(const Frame& F, const Args& a, int l, float* xl, float* xc, const float* xl_in, const float* xc_in) {
    const float* MOD = (const float*)(a.ws + WS_MOD); bf16* H = (bf16*)(a.ws + WS_H);
    const bf16* Y = (const bf16*)(a.ws + WS_Y); const float* GSL = (const float*)(a.ws + WS_GSL); const short* INV = (const short*)(a.ws + WS_INV);
    float* AFF = (float*)(a.ws + WS_AFF);
    constexpr bool combine = (MODE == 2) || (MODE == 3);
    constexpr bool N1 = (MODE == 0 || MODE == 3);
    const int lc = (MODE == 2) ? DEPTH - 1 : l - 1;
    const int nrows = (MODE == 2) ? ML : ((MODE == 1 && l == DEPTH - 1) ? ML : MT);
    LAS float* WR = (LAS float*)F.lds;
    if (MODE == 1) { const float* wr = a.w_router + (size_t)l * D * NE; __syncthreads();
        {
#pragma unroll 1
            for (int it0 = 0; it0 < 16; it0 += 8) { f32x4 t4[8];
#pragma unroll
                for (int u = 0; u < 8; ++u) t4[u] = *(const f32x4*)(wr + 4 * (F.tid + 512 * (it0 + u)));
#pragma unroll
                for (int u = 0; u < 8; ++u) { const int i4 = F.tid + 512 * (it0 + u), k = i4 >> 2, e0 = 4 * (i4 & 3);
                    WR[(e0 + 0) * D + k] = t4[u][0]; WR[(e0 + 1) * D + k] = t4[u][1]; WR[(e0 + 2) * D + k] = t4[u][2]; WR[(e0 + 3) * D + k] = t4[u][3]; } } }
        __syncthreads(); }
    const int gw = F.c * 8 + F.wave, NGW = F.G * 8;
    const int rpw = (nrows + NGW - 1) / NGW; const int m0 = gw * rpw; int m1 = m0 + rpw; m1 = m1 > nrows ? nrows : m1;
    const float* nw = (MODE == 1 ? a.norm2_w : a.norm1_w) + (size_t)(MODE == 2 ? 0 : l) * D; (void)N1;
    const int ko = 4 * F.lane;
    f32x4 vA[8], vB[8], vG[8];
    int scur = -1;
    f32x4 v[8];
    if (m0 < m1) { const float* xin = m0 >= ML ? xc_in + (size_t)(m0 - ML) * D : xl_in + (size_t)m0 * D;
#pragma unroll
        for (int j = 0; j < 8; ++j) v[j] = *(const f32x4*)(xin + 256 * j + ko); }
#pragma unroll 1
    for (int m = m0; m < m1; ++m) {
        const bool isctx = m >= ML; const int s = isctx ? 8 : (m >> 12);
        float* xo = isctx ? xc + (size_t)(m - ML) * D : xl + (size_t)m * D;
        if (s != scur) { scur = s;
            if (MODE != 2) { const int ch = (MODE == 1) ? 3 : 0;
                const float* msh = MOD + ((size_t)l * 9 + s) * (6 * D) + (size_t)ch * D; const float* bsh = a.b_ada + (size_t)l * 6 * D + (size_t)ch * D;
#pragma unroll
                for (int j = 0; j < 8; ++j) { const int k = 256 * j + ko;
                    f32x4 t0 = *(const f32x4*)(msh + k), t1 = *(const f32x4*)(bsh + k), t2 = *(const f32x4*)(nw + k), t3 = *(const f32x4*)(msh + D + k), t4 = *(const f32x4*)(bsh + D + k);
                    asm volatile("" : "+v"(t0), "+v"(t1), "+v"(t2), "+v"(t3), "+v"(t4));
                    vB[j] = t0 + t1; vA[j] = t2 * (1.0f + (t3 + t4)); } }
            if (combine && MODE == 2) { const float* mg = MOD + ((size_t)lc * 9 + s) * (6 * D) + 5 * D; const float* bg = a.b_ada + (size_t)lc * 6 * D + 5 * D;
#pragma unroll
                for (int j = 0; j < 8; ++j) vG[j] = *(const f32x4*)(mg + 256 * j + ko) + *(const f32x4*)(bg + 256 * j + ko); }
        }
        f32x4 vn[8];
        if (MODE != 3 && m + 1 < m1) { const int mn = m + 1; const float* xin = mn >= ML ? xc_in + (size_t)(mn - ML) * D : xl_in + (size_t)mn * D;
#pragma unroll
            for (int j = 0; j < 8; ++j) vn[j] = *(const f32x4*)(xin + 256 * j + ko); }
        if (combine) {
            f32x4 acc[8];
#pragma unroll
            for (int j = 0; j < 8; ++j) acc[j] = (f32x4){0.f, 0.f, 0.f, 0.f};
            const int myinv = F.lane < NE ? (int)INV[(size_t)m * NE + F.lane] : -1;
            unsigned emask = (unsigned)(__ballot(myinv >= 0) & 0xFFFFull);
            while (emask) {
                const int e1 = __builtin_ctz(emask); emask &= emask - 1u; const int sl1 = __builtin_amdgcn_readlane(myinv, e1);
                const bool two = emask != 0u; const int e2 = two ? __builtin_ctz(emask) : e1; if (two) emask &= emask - 1u; const int sl2 = __builtin_amdgcn_readlane(myinv, e2);
                const bf16* y1 = Y + ((size_t)e1 * RPE + sl1) * D; const bf16* y2 = Y + ((size_t)e2 * RPE + sl2) * D;
                u32x2 ya[8], yb[8];
#pragma unroll
                for (int j = 0; j < 8; ++j) { ya[j] = *(const u32x2*)(y1 + 256 * j + ko); yb[j] = *(const u32x2*)(y2 + 256 * j + ko); }
                float g1, g2;
                if constexpr (MODE == 2) {
                    int s1v = sl1, s2v = sl2; asm volatile("" : "+v"(s1v), "+v"(s2v));
                    g1 = GSL[(size_t)e1 * RPE + s1v]; g2 = GSL[(size_t)e2 * RPE + s2v];
                    asm volatile("" : "+v"(ya[0]), "+v"(ya[1]), "+v"(ya[2]), "+v"(ya[3]), "+v"(ya[4]), "+v"(ya[5]), "+v"(ya[6]), "+v"(ya[7]), "+v"(yb[0]), "+v"(yb[1]), "+v"(yb[2]), "+v"(yb[3]),
                                 "+v"(yb[4]), "+v"(yb[5]), "+v"(yb[6]), "+v"(yb[7]), "+v"(g1), "+v"(g2));
                } else { g1 = GSL[(size_t)e1 * RPE + sl1]; g2 = two ? GSL[(size_t)e2 * RPE + sl2] : 0.f;
                    asm volatile("" : "+v"(ya[0]), "+v"(ya[1]), "+v"(ya[2]), "+v"(ya[3]), "+v"(ya[4]), "+v"(ya[5]), "+v"(ya[6]), "+v"(ya[7]), "+v"(yb[0]), "+v"(yb[1]), "+v"(yb[2]), "+v"(yb[3]),
                                 "+v"(yb[4]), "+v"(yb[5]), "+v"(yb[6]), "+v"(yb[7])); }
#pragma unroll
                for (int j = 0; j < 8; ++j) { acc[j][0] += g1 * bflo(ya[j].x); acc[j][1] += g1 * bfhi(ya[j].x); acc[j][2] += g1 * bflo(ya[j].y); acc[j][3] += g1 * bfhi(ya[j].y); }
                if (two) {
#pragma unroll
                    for (int j = 0; j < 8; ++j) { acc[j][0] += g2 * bflo(yb[j].x); acc[j][1] += g2 * bfhi(yb[j].x); acc[j][2] += g2 * bflo(yb[j].y); acc[j][3] += g2 * bfhi(yb[j].y); } }
            }
            if (MODE == 2) {
#pragma unroll
                for (int j = 0; j < 8; ++j) { v[j] += vG[j] * acc[j]; *(f32x4*)(xo + 256 * j + ko) = v[j]; }
            } else { const float* mg = MOD + ((size_t)lc * 9 + s) * (6 * D) + 5 * D; const float* bg = a.b_ada + (size_t)lc * 6 * D + 5 * D;
#pragma unroll
                for (int hq = 0; hq < 2; ++hq) { f32x4 g0[4], g1[4];
#pragma unroll
                    for (int jj = 0; jj < 4; ++jj) { g0[jj] = *(const f32x4*)(mg + 256 * (4 * hq + jj) + ko); g1[jj] = *(const f32x4*)(bg + 256 * (4 * hq + jj) + ko); }
                    asm volatile("" : "+v"(g0[0]), "+v"(g0[1]), "+v"(g0[2]), "+v"(g0[3]), "+v"(g1[0]), "+v"(g1[1]), "+v"(g1[2]), "+v"(g1[3]));
#pragma unroll
                    for (int jj = 0; jj < 4; ++jj) { const int j = 4 * hq + jj; v[j] += (g0[jj] + g1[jj]) * acc[j]; *(f32x4*)(xo + 256 * j + ko) = v[j]; } }
            }
        }
        if (MODE != 2) {
            float ss = 0.f;
#pragma unroll
            for (int j = 0; j < 8; ++j) ss += (v[j][0] * v[j][0] + v[j][1] * v[j][1]) + (v[j][2] * v[j][2] + v[j][3] * v[j][3]);
            const float rs = 1.0f / sqrtf(wave_sum(ss) * (1.0f / D) + EPS);
#pragma unroll
            for (int j = 0; j < 8; ++j) { v[j] = (v[j] * rs) * vA[j] + vB[j];
                if (MODE == 1) *(unsigned*)((unsigned char*)H + (size_t)m * D + 256 * j + ko) = cvt4_fp8(v[j][0], v[j][1], v[j][2], v[j][3]);
                else { u32x2 o; o.x = cvt_pk(v[j][0], v[j][1]); o.y = cvt_pk(v[j][2], v[j][3]); *(u32x2*)(H + (size_t)m * D + 256 * j + ko) = o;
                    *(unsigned*)(a.ws + WS_H8 + (size_t)m * D + 256 * j + ko) = cvt4_fp8(v[j][0], v[j][1], v[j][2], v[j][3]); } }
            if (MODE == 1) {
                float p[NE];
#pragma unroll
                for (int e = 0; e < NE; ++e) { float q = 0.f;
#pragma unroll
                    for (int j = 0; j < 8; ++j) { const f32x4 w = *(const LAS f32x4*)(WR + e * D + 256 * j + ko); q += (v[j][0] * w[0] + v[j][1] * w[1]) + (v[j][2] * w[2] + v[j][3] * w[3]); }
                    p[e] = q; if (e & 1) __builtin_amdgcn_sched_barrier(0); }
                float r1[8], r2[4], r3[2], r4;
                { const bool hi = (F.lane & 32) != 0;
#pragma unroll
                  for (int i = 0; i < 8; ++i) { const float keep = hi ? p[8 + i] : p[i], send = hi ? p[i] : p[8 + i]; r1[i] = keep + shx(send, 32); } }
                { const bool hi = (F.lane & 16) != 0;
#pragma unroll
                  for (int i = 0; i < 4; ++i) { const float keep = hi ? r1[4 + i] : r1[i], send = hi ? r1[i] : r1[4 + i]; r2[i] = keep + shx(send, 16); } }
                { const bool hi = (F.lane & 8) != 0;
#pragma unroll
                  for (int i = 0; i < 2; ++i) { const float keep = hi ? r2[2 + i] : r2[i], send = hi ? r2[i] : r2[2 + i]; r3[i] = keep + shx(send, 8); } }
                { const bool hi = (F.lane & 4) != 0; const float keep = hi ? r3[1] : r3[0], send = hi ? r3[0] : r3[1]; r4 = keep + shx(send, 4); }
                r4 += shx(r4, 2); r4 += shx(r4, 1);
                float mx = r4;
                mx = fmaxf(mx, shx(mx, 4)); mx = fmaxf(mx, shx(mx, 8)); mx = fmaxf(mx, shx(mx, 16)); mx = fmaxf(mx, shx(mx, 32));
                const float ex = __expf(r4 - mx); float den = ex;
                den += shx(den, 4); den += shx(den, 8); den += shx(den, 16); den += shx(den, 32);
                const int e = ((F.lane >> 5) & 1) * 8 + ((F.lane >> 4) & 1) * 4 + ((F.lane >> 3) & 1) * 2 + ((F.lane >> 2) & 1);
                const int set = isctx ? 8 + ((m - ML) >> 8) : (m >> 12); const int n = isctx ? ((m - ML) & 255) : (m & 4095);
                if ((F.lane & 3) == 0) __hip_atomic_store(AFF + ((size_t)set * NE + e) * SEQ + n, ex / den, __ATOMIC_RELAXED, __HIP_MEMORY_SCOPE_AGENT);
            }
        }
        if (MODE != 3) {
#pragma unroll
            for (int j = 0; j < 8; ++j) v[j] = vn[j];
        } else if (m + 1 < m1) { const int mn = m + 1; const float* xin = mn >= ML ? xc_in + (size_t)(mn - ML) * D : xl_in + (size_t)mn * D;
#pragma unroll
            for (int j = 0; j < 8; ++j) v[j] = *(const f32x4*)(xin + 256 * j + ko); }
    }
}

__device__ __forceinline__ void convpool_phase(const Frame& F, const Args& a, int l, int nrows) {
    const bf16* P = (const bf16*)(a.ws + WS_P); const bf16* GB = (const bf16*)(a.ws + WS_GB); const bf16* ZP = (const bf16*)(a.ws + WS_ZP); bf16* BR = (bf16*)(a.ws + WS_BR);
    const float* cw = a.conv_w + (size_t)l * 3 * MIXW;
    const int gw = F.c * 8 + F.wave, NGW = F.G * 8; const int ch = F.lane * 8; const int nruns = nrows / 8, npruns = nrows / 4;
    const int g = ch >> 7, win = 2 << g, wlo = win / 2, whi = win - win / 2 - 1;
#pragma unroll 1
    for (int it = gw; it < nruns + npruns; it += NGW) {
        const bool is_pool = it >= nruns; const int m0 = is_pool ? (it - nruns) * 4 : it * 8; const bool isctx = m0 >= ML;
        const int t0 = isctx ? ((m0 - ML) & 255) : (m0 & 4095); const int n = isctx ? LC : SEQ;
        if (!is_pool) {
            float w0[8], w1[8], w2[8];
#pragma unroll
            for (int q = 0; q < 8; ++q) { w0[q] = cw[ch + q]; w1[q] = cw[MIXW + ch + q]; w2[q] = cw[2 * MIXW + ch + q]; }
            u32x4 pr[10], gb[8]; const u32x4 z = (u32x4){0u, 0u, 0u, 0u};
#pragma unroll
            for (int i = 0; i < 10; ++i) { const int t = t0 - 1 + i; pr[i] = (t >= 0 && t < n) ? *(const u32x4*)(P + (size_t)(m0 - 1 + i) * 512 + ch) : z; }
#pragma unroll
            for (int i = 0; i < 8; ++i) gb[i] = *(const u32x4*)(GB + (size_t)(m0 + i) * 512 + ch);
#pragma unroll
            for (int i = 0; i < 8; ++i) { float o[8];
#pragma unroll
                for (int q = 0; q < 4; ++q) {
                    o[2 * q] = bflo(gb[i][q]) * (w0[2 * q] * bflo(pr[i][q]) + w1[2 * q] * bflo(pr[i + 1][q]) + w2[2 * q] * bflo(pr[i + 2][q]));
                    o[2 * q + 1] = bfhi(gb[i][q]) * (w0[2 * q + 1] * bfhi(pr[i][q]) + w1[2 * q + 1] * bfhi(pr[i + 1][q]) + w2[2 * q + 1] * bfhi(pr[i + 2][q])); }
                u32x4 w; w.x = cvt_pk(o[0], o[1]); w.y = cvt_pk(o[2], o[3]); w.z = cvt_pk(o[4], o[5]); w.w = cvt_pk(o[6], o[7]);
                *(u32x4*)(BR + (size_t)(m0 + i) * D + ch) = w; }
        } else {
            float acc[4][8];
#pragma unroll
            for (int i = 0; i < 4; ++i)
#pragma unroll
                for (int q = 0; q < 8; ++q) acc[i][q] = 0.f;
            u32x4 self[4];
#pragma unroll
            for (int r = 0; r < 19; ++r) { const int t = t0 - 8 + r; const bool inr = (t >= 0 && t < n);
                u32x4 zr = (u32x4){0u, 0u, 0u, 0u}; if (inr) zr = *(const u32x4*)(ZP + (size_t)(m0 - 8 + r) * 512 + ch);
                if (r >= 8 && r < 12) self[r - 8] = zr;
                float f[8];
#pragma unroll
                for (int q = 0; q < 4; ++q) { f[2 * q] = bflo(zr[q]); f[2 * q + 1] = bfhi(zr[q]); }
#pragma unroll
                for (int i = 0; i < 4; ++i) { const int d = r - 8 - i;
                    if (d >= -8 && d <= 7) { const bool use = (d >= -wlo) && (d <= whi);
#pragma unroll
                        for (int q = 0; q < 8; ++q) acc[i][q] += use ? f[q] : 0.f; } }
                if ((r & 7) == 7) __builtin_amdgcn_sched_barrier(0); }
#pragma unroll
            for (int i = 0; i < 4; ++i) { const int t = t0 + i; int lo = t - wlo; lo = lo < 0 ? 0 : lo; int hi = t + whi; hi = hi > n - 1 ? n - 1 : hi; const float ic = 1.0f / (float)(hi - lo + 1);
                float o[8];
#pragma unroll
                for (int q = 0; q < 4; ++q) { o[2 * q] = acc[i][2 * q] * ic - bflo(self[i][q]); o[2 * q + 1] = acc[i][2 * q + 1] * ic - bfhi(self[i][q]); }
                u32x4 w; w.x = cvt_pk(o[0], o[1]); w.y = cvt_pk(o[2], o[3]); w.z = cvt_pk(o[4], o[5]); w.w = cvt_pk(o[6], o[7]);
                *(u32x4*)(BR + (size_t)(m0 + i) * D + 1536 + ch) = w; }
        }
    }
}

template <bool LOCAL>
__device__ __forceinline__ void attn_step(const bf16x8 (&kf)[2][2], const u32x4 (&vf)[4], const bf16x8 q0, const bf16x8 q1, const LAS float* rpbrow, const bool (&okA)[2][4],
                                          f32x4 (&o)[4], const float negB, float& lrun) {
    f32x4 s0 = (f32x4){0.f, 0.f, 0.f, 0.f}, s1 = s0;
    s0 = __builtin_amdgcn_mfma_f32_16x16x32_bf16(kf[0][0], q0, s0, 0, 0, 0); s0 = __builtin_amdgcn_mfma_f32_16x16x32_bf16(kf[0][1], q1, s0, 0, 0, 0);
    s1 = __builtin_amdgcn_mfma_f32_16x16x32_bf16(kf[1][0], q0, s1, 0, 0, 0); s1 = __builtin_amdgcn_mfma_f32_16x16x32_bf16(kf[1][1], q1, s1, 0, 0, 0);
    if (LOCAL) {
#pragma unroll
        for (int j = 0; j < 4; ++j) { const float b0 = rpbrow[j], b1 = rpbrow[4 + j]; const float t0 = s0[j] + b0, t1 = s1[j] + b1;
            s0[j] = okA[0][j] ? t0 : -1e30f; s1[j] = okA[1][j] ? t1 : -1e30f; }
    }
    else {
#pragma unroll
        for (int j = 0; j < 4; ++j) { s0[j] += negB; s1[j] += negB; }
    }
#pragma unroll
    for (int j = 0; j < 4; ++j) { s0[j] = __builtin_amdgcn_exp2f(s0[j]); s1[j] = __builtin_amdgcn_exp2f(s1[j]); }
    lrun += ((s0[0] + s0[1]) + (s0[2] + s0[3])) + ((s1[0] + s1[1]) + (s1[2] + s1[3]));
    u32x4 pw; pw.x = cvt_pk(s0[0], s0[1]); pw.y = cvt_pk(s0[2], s0[3]); pw.z = cvt_pk(s1[0], s1[1]); pw.w = cvt_pk(s1[2], s1[3]);
    const bf16x8 pb = __builtin_bit_cast(bf16x8, pw);
#pragma unroll
    for (int dt = 0; dt < 4; ++dt) o[dt] = __builtin_amdgcn_mfma_f32_16x16x32_bf16(__builtin_bit_cast(bf16x8, vf[dt]), pb, o[dt], 0, 0, 0);
}
template <bool LOCAL>
__device__ __forceinline__ void attn_group(const Frame& F, const Args& a, const LAS float* rpbL, const float negB, int b, int h, int rg, int nb) {
    const bf16* Q = (const bf16*)(a.ws + WS_Q); const char* KB = (const char*)(a.ws + WS_KB); const char* VT = (const char*)(a.ws + WS_VT);
    bf16* BR = (bf16*)(a.ws + WS_BR);
    LAS unsigned char* ring = F.lds + F.wave * 16384;
    const int lane = fresh_tid(0), kl = lane & 15, kq = lane >> 4;
    const unsigned qrow0 = LOCAL ? (unsigned)(b * SEQ + 64 * (4 * rg) + 16 * nb + kl) : (unsigned)(ML + b * LC + 64 * rg + kl); constexpr unsigned QSTEP = LOCAL ? 64u : 16u;
    bf16x8 q0[4], q1[4];
#pragma unroll
    for (int qi = 0; qi < 4; ++qi) { const bf16x8* qp = (const bf16x8*)(Q + (size_t)(qrow0 + QSTEP * qi) * 512 + 64 * h + 16 * kq); q0[qi] = qp[0]; q1[qi] = qp[1]; }
    f32x4 o[4][4]; float lrun[4];
#pragma unroll
    for (int qi = 0; qi < 4; ++qi) { lrun[qi] = 0.f;
#pragma unroll
        for (int dt = 0; dt < 4; ++dt) o[qi][dt] = (f32x4){0.f, 0.f, 0.f, 0.f}; }
    bool okA[2][4]; const LAS float* rpbl = rpbL; int rlo = 0, nloc = 0; unsigned kcur, vcur;
    const unsigned dkc = (unsigned)(((lane & 7) ^ ((lane >> 4) & 1)) * 16), dvc = (unsigned)(((lane & 3) ^ ((lane >> 4) & 3)) * 16);
    const unsigned rdk = (unsigned)((8 * (kl >> 2) + (kl & 3)) * 128 + (((2 * kq) ^ (((kl >> 2) << 1) | ((kl >> 1) & 1))) * 16)), rdv = (unsigned)(4096 + kl * 64 + ((kq ^ (kl >> 2)) * 16));
    if (LOCAL) {
        int kbs = 16 * nb - 8; kbs = kbs < 0 ? 0 : (kbs > 32 ? 32 : kbs);
        const int qcol = 16 * nb + kl; int cs = qcol - 8; cs = cs < 0 ? 0 : (cs > 48 ? 48 : cs);
        const int dc0 = kbs + 8 * kq - qcol + 15;
        rpbl = rpbL + h * 480 + dc0;
#pragma unroll
        for (int hf = 0; hf < 2; ++hf)
#pragma unroll
            for (int j = 0; j < 4; ++j) { const int kc = kbs + 8 * kq + 4 * hf + j; okA[hf][j] = (kc >= cs) && (kc < cs + 16); }
        rlo = 4 * rg - 4; rlo = rlo < 0 ? 0 : (rlo > 56 ? 56 : rlo); int rhi = 4 * rg + 3 - 4; rhi = rhi < 0 ? 0 : (rhi > 56 ? 56 : rhi); rhi += 7; nloc = rhi - rlo + 1;
        kcur = (unsigned)(((b * SEQ + 64 * rlo + kbs + (lane >> 3)) * 512 + 64 * h) * 2) + dkc; vcur = (unsigned)((((b * NH + h) * HD + (lane >> 2)) * SEQ + 64 * rlo + kbs) * 2) + dvc;
    } else {
        kcur = (unsigned)(((ML + b * LC + (lane >> 3)) * 512 + 64 * h) * 2) + dkc; vcur = (unsigned)SZ_VT + (unsigned)((((b * NH + h) * HD + (lane >> 2)) * LC) * 2) + dvc;
    }
    const int ntot = nloc + 8;
    int pi = 0;
#define ATT_ISSUE() { const bool loc = LOCAL && (pi < nloc); const unsigned vs = loc ? (unsigned)(16 * SEQ * 2) : (unsigned)(16 * LC * 2); \
        LAS unsigned* dst = (LAS unsigned*)(ring + (pi & 1) * 8192); \
        _Pragma("unroll") for (int pc = 0; pc < 4; ++pc) __builtin_amdgcn_global_load_lds((const unsigned*)(KB + ((kcur ^ (unsigned)(pc * 32)) + (unsigned)(pc * 8192))), dst + pc * 256, 16, 0, 0); \
        _Pragma("unroll") for (int dt = 0; dt < 4; ++dt) __builtin_amdgcn_global_load_lds((const unsigned*)(VT + (vcur + (unsigned)dt * vs)), dst + (4 + dt) * 256, 16, 0, 0); \
        ++pi; \
        if (LOCAL && pi == nloc) { const int l3 = fresh_tid(0); \
            kcur = (unsigned)(((ML + b * LC + (l3 >> 3)) * 512 + 64 * h) * 2) + (unsigned)(((l3 & 7) ^ ((l3 >> 4) & 1)) * 16); \
            vcur = (unsigned)SZ_VT + (unsigned)((((b * NH + h) * HD + (l3 >> 2)) * LC) * 2) + (unsigned)(((l3 & 3) ^ ((l3 >> 4) & 3)) * 16); } \
        else { kcur += loc ? 65536u : 32768u; vcur += loc ? 128u : 64u; } }
    ATT_ISSUE() ATT_ISSUE()
    __builtin_amdgcn_s_waitcnt(0x4F70);
#define ATT_ROW_BEGIN() \
        if (ci + 1 < ntot) asm volatile("s_waitcnt vmcnt(8)" ::: "memory"); else asm volatile("s_waitcnt vmcnt(0)" ::: "memory"); \
        bf16x8 kf[2][2]; u32x4 vf[4]; \
        { LAS unsigned char* sl = ring + (ci & 1) * 8192; \
          kf[0][0] = *(const LAS bf16x8*)(sl + rdk); kf[0][1] = *(const LAS bf16x8*)(sl + (rdk ^ 16u)); kf[1][0] = *(const LAS bf16x8*)(sl + rdk + 512); kf[1][1] = *(const LAS bf16x8*)(sl + (rdk ^ 16u) + 512); \
          _Pragma("unroll") for (int dt = 0; dt < 4; ++dt) vf[dt] = *(const LAS u32x4*)(sl + rdv + dt * 1024); }
#define ATT_ROW_END() \
        asm volatile("s_waitcnt lgkmcnt(0)" ::: "memory"); \
        if (pi < ntot) ATT_ISSUE()
    int ci = 0;
    if (LOCAL) {
#pragma unroll 1
        for (; ci < nloc; ++ci) {
            ATT_ROW_BEGIN()
            const int kr = rlo + ci;
#pragma unroll
            for (int qi = 0; qi < 4; ++qi) { const int r = 4 * rg + qi; int rs = r - 4; rs = rs < 0 ? 0 : (rs > 56 ? 56 : rs);
                if (kr >= rs && kr < rs + 8) attn_step<true>(kf, vf, q0[qi], q1[qi], rpbl + (kr - r + 7) * 32, okA, o[qi], negB, lrun[qi]); }
            ATT_ROW_END()
        }
    }
#pragma unroll 1
    for (; ci < ntot; ++ci) {
        ATT_ROW_BEGIN()
#pragma unroll
        for (int qi = 0; qi < 4; ++qi) attn_step<false>(kf, vf, q0[qi], q1[qi], rpbL, okA, o[qi], negB, lrun[qi]);
        ATT_ROW_END()
    }
#undef ATT_ROW_BEGIN
#undef ATT_ROW_END
#undef ATT_ISSUE
    const int lane2 = fresh_tid(0), kl2 = lane2 & 15, kq2 = lane2 >> 4;
    const unsigned qrow2 = LOCAL ? (unsigned)(b * SEQ + 64 * (4 * rg) + 16 * nb + kl2) : (unsigned)(ML + b * LC + 64 * rg + kl2);
#pragma unroll
    for (int qi = 0; qi < 4; ++qi) { float l = lrun[qi];
        l += __builtin_bit_cast(float, __builtin_amdgcn_ds_bpermute((lane2 ^ 16) << 2, __builtin_bit_cast(int, l))); l += __builtin_bit_cast(float, __builtin_amdgcn_ds_bpermute((lane2 ^ 32) << 2, __builtin_bit_cast(int, l)));
        const float il = 1.0f / l;
#pragma unroll
        for (int dt = 0; dt < 4; ++dt) { u32x2 w; w.x = cvt_pk(o[qi][dt][0] * il, o[qi][dt][1] * il); w.y = cvt_pk(o[qi][dt][2] * il, o[qi][dt][3] * il);
            *(u32x2*)(BR + (size_t)(qrow2 + QSTEP * qi) * D + 512 + 64 * h + 16 * dt + 4 * kq2) = w; } }
}
__device__ __forceinline__ void attn_phase(const Frame& F, const Args& a, int l, bool do_ctx) {
    LAS float* rpbL = (LAS float*)(F.lds + IDX_OFF) + 64;
    __syncthreads();
    {   float rv[8];
#pragma unroll
        for (int u = 0; u < 8; ++u) { const int i = F.tid + 512 * u, h = i / 480, r = (i % 480) >> 5, cdx = i & 31; rv[u] = (i < NH * 15 * 32 && cdx < 31) ? a.na_rpb[(((size_t)l * NH + h) * 15 + r) * 31 + cdx] * LOG2E : 0.f; }
#pragma unroll
        for (int u = 0; u < 8; ++u) { const int i = F.tid + 512 * u; if (i < NH * 15 * 32) rpbL[i] = rv[u]; } }
    __syncthreads();
    float negB;
    { float mq = 0.f, mk = 0.f, mb = 0.f; const float* qw = a.q_norm_w + (size_t)l * HD; const float* kw = a.k_norm_w + (size_t)l * HD;
      mq = fabsf(qw[F.lane]); mk = fabsf(kw[F.lane]);
      for (int i = F.lane; i < NH * 15 * 32; i += 64) mb = fmaxf(mb, fabsf(rpbL[i]));
#pragma unroll
      for (int o = 1; o < 64; o <<= 1) { const int src = (F.lane ^ o) << 2;
          mq = fmaxf(mq, __builtin_bit_cast(float, __builtin_amdgcn_ds_bpermute(src, __builtin_bit_cast(int, mq)))); mk = fmaxf(mk, __builtin_bit_cast(float, __builtin_amdgcn_ds_bpermute(src, __builtin_bit_cast(int, mk))));
          mb = fmaxf(mb, __builtin_bit_cast(float, __builtin_amdgcn_ds_bpermute(src, __builtin_bit_cast(int, mb)))); }
      negB = -(64.0f * 0.125f * LOG2E * mq * mk * 1.02f + mb + 0.5f);
      negB = __builtin_bit_cast(float, __builtin_amdgcn_readfirstlane(__builtin_bit_cast(int, negB))); }
    __syncthreads();
    for (int i = F.tid; i < NH * 15 * 32; i += 512) rpbL[i] += negB;
    __syncthreads();
#pragma unroll 1
    for (int id = F.c * 8 + F.wave; id < NB * NH * 16 * 4; id += F.G * 8) {
        const int nb = id & 3, rg = (id >> 2) & 15, h = (id >> 6) & 7, b = id >> 9;
        attn_group<true>(F, a, rpbL, negB, b, h, rg, nb);
    }
    if (do_ctx) {
#pragma unroll 1
        for (int id = F.c * 8 + F.wave; id < NB * NH * 4; id += F.G * 8) {
            const int g = id & 3, h = (id >> 2) & 7, b = id >> 5;
            attn_group<false>(F, a, rpbL, negB, b, h, g, 0);
        }
    }
    __syncthreads();
}

__device__ __forceinline__ void fft_tables(const Frame& F, LAS float* t64, LAS float* tw) {
    __syncthreads();
    if (F.tid < 64) { float sv, cv; sincospif((float)F.tid * (2.0f / 64.0f), &sv, &cv); t64[2 * F.tid] = cv; t64[2 * F.tid + 1] = sv; }
    if (tw) for (int i = F.tid; i < 4096; i += 512) { float sv, cv; sincospif((float)i * (2.0f / 4096.0f), &sv, &cv); tw[2 * i] = cv; tw[2 * i + 1] = sv; }
    __syncthreads();
}
__device__ __forceinline__ void fft_stage1(const Frame& F, const Args& a) {
    LAS float* t64 = (LAS float*)F.lds; LAS float* tw = (LAS float*)(F.lds + 1024);
    fft_tables(F, t64, tw);
    const bf16* TT2 = (const bf16*)(a.ws + WS_TT); bf16* S2 = (bf16*)(a.ws + WS_S2);
    const int c = F.lane & 15, kq = F.lane >> 4;
    bf16x8 wf[8][4];
#pragma unroll
    for (int j = 0; j < 8; ++j)
#pragma unroll
        for (int st = 0; st < 4; ++st) { float v[8];
#pragma unroll
            for (int i = 0; i < 8; ++i) { const int col = 16 * j + c, k1 = col >> 1, ro = col & 1, kk = 32 * st + 8 * kq + i, part = kk >> 6, n1 = kk & 63, idx = (k1 * n1) & 63;
                const float cs = t64[2 * idx], sn = t64[2 * idx + 1]; v[i] = ro == 0 ? (part == 0 ? cs : -sn) : (part == 0 ? -sn : -cs); }
            u32x4 w; w.x = cvt_pk(v[0], v[1]); w.y = cvt_pk(v[2], v[3]); w.z = cvt_pk(v[4], v[5]); w.w = cvt_pk(v[6], v[7]); wf[j][st] = __builtin_bit_cast(bf16x8, w); }
    const int gw = F.c * 8 + F.wave, NGW = F.G * 8;
    bf16x8 af[4];
    { const int T = gw < NB * 512 * 4 ? gw : 0; const int b = T >> 11, cp = (T >> 2) & 511, n2 = 16 * (T & 3) + c; const bf16* ar = TT2 + (((size_t)(b * 512 + cp) * 64 + n2) * 128) + 8 * kq;
#pragma unroll
      for (int st = 0; st < 4; ++st) af[st] = *(const bf16x8*)(ar + 32 * st); }
#pragma unroll 1
    for (int T = gw; T < NB * 512 * 4; T += NGW) {
        const int b = T >> 11, cp = (T >> 2) & 511, n2 = 16 * (T & 3) + c;
        bf16x8 an[4];
        { const int Tn = T + NGW < NB * 512 * 4 ? T + NGW : T; const int bn = Tn >> 11, cpn = (Tn >> 2) & 511, n2n = 16 * (Tn & 3) + c; const bf16* arn = TT2 + (((size_t)(bn * 512 + cpn) * 64 + n2n) * 128) + 8 * kq;
#pragma unroll
          for (int st = 0; st < 4; ++st) an[st] = *(const bf16x8*)(arn + 32 * st); }
        f32x4 acc[8];
#pragma unroll
        for (int j = 0; j < 8; ++j) { acc[j] = (f32x4){0.f, 0.f, 0.f, 0.f};
#pragma unroll
            for (int st = 0; st < 4; ++st) acc[j] = __builtin_amdgcn_mfma_f32_16x16x32_bf16(wf[j][st], af[st], acc[j], 0, 0, 0); }
#pragma unroll
        for (int j = 0; j < 8; ++j)
#pragma unroll
            for (int hh = 0; hh < 2; ++hh) { const int k1 = 8 * j + 2 * kq + hh; const float xr = acc[j][2 * hh], xi = acc[j][2 * hh + 1]; const int mm = k1 * n2;
                const float cs = tw[2 * mm], sn = tw[2 * mm + 1];
                *(unsigned*)(S2 + (((size_t)(b * 64 + k1) * 512 + cp) * 128 + 2 * n2)) = cvt_pk(xr * cs + xi * sn, xi * cs - xr * sn); }
#pragma unroll
        for (int st = 0; st < 4; ++st) af[st] = an[st];
    }
    __syncthreads();
}
__device__ __forceinline__ void fft_stage3(const Frame& F, const Args& a) {
    LAS float* t64 = (LAS float*)F.lds;
    fft_tables(F, t64, nullptr);
    const bf16* S2 = (const bf16*)(a.ws + WS_S2); bf16* BR = (bf16*)(a.ws + WS_BR);
    const int c = F.lane & 15, kq = F.lane >> 4;
    bf16x8 wf[4][4];
#pragma unroll
    for (int j = 0; j < 4; ++j)
#pragma unroll
        for (int st = 0; st < 4; ++st) { float v[8];
#pragma unroll
            for (int i = 0; i < 8; ++i) { const int k2 = 16 * j + c, kk = 32 * st + 8 * kq + i, n2 = kk >> 1, ri = kk & 1, idx = (k2 * n2) & 63; v[i] = t64[2 * idx + ri] * (1.0f / 64.0f); }
            u32x4 w; w.x = cvt_pk(v[0], v[1]); w.y = cvt_pk(v[2], v[3]); w.z = cvt_pk(v[4], v[5]); w.w = cvt_pk(v[6], v[7]); wf[j][st] = __builtin_bit_cast(bf16x8, w); }
    const int gw = F.c * 8 + F.wave, NGW = F.G * 8;
    bf16x8 af[4];
    { const int T = gw < NB * 64 * 32 ? gw : 0; const bf16* ar = S2 + (((size_t)(T >> 5) * 512 + 16 * (T & 31) + c) * 128) + 8 * kq;
#pragma unroll
      for (int st = 0; st < 4; ++st) af[st] = *(const bf16x8*)(ar + 32 * st); }
#pragma unroll 1
    for (int T = gw; T < NB * 64 * 32; T += NGW) {
        const int bk = T >> 5, b = bk >> 6, k1 = bk & 63, cp = 16 * (T & 31) + c;
        bf16x8 an[4];
        { const int Tn = T + NGW < NB * 64 * 32 ? T + NGW : T; const bf16* arn = S2 + (((size_t)(Tn >> 5) * 512 + 16 * (Tn & 31) + c) * 128) + 8 * kq;
#pragma unroll
          for (int st = 0; st < 4; ++st) an[st] = *(const bf16x8*)(arn + 32 * st); }
        f32x4 acc[4];
#pragma unroll
        for (int j = 0; j < 4; ++j) { acc[j] = (f32x4){0.f, 0.f, 0.f, 0.f};
#pragma unroll
            for (int st = 0; st < 4; ++st) acc[j] = __builtin_amdgcn_mfma_f32_16x16x32_bf16(wf[j][st], af[st], acc[j], 0, 0, 0); }
        asm volatile("s_nop 15\n\ts_nop 15" : "+v"(acc[0]), "+v"(acc[1]), "+v"(acc[2]), "+v"(acc[3]));
#pragma unroll
        for (int j = 0; j < 4; ++j)
#pragma unroll
            for (int jj = 0; jj < 4; ++jj) { const int k2 = 16 * j + 4 * kq + jj; BR[((size_t)b * SEQ + k1 + 64 * k2) * D + 1024 + cp] = f2bf(acc[j][jj]); }
#pragma unroll
        for (int st = 0; st < 4; ++st) af[st] = an[st];
    }
    __syncthreads();
}

__device__ __forceinline__ void topk_phase(const Frame& F, const Args& a, int nsets) {
    const float* AFF = (const float*)(a.ws + WS_AFF); float* GSL = (float*)(a.ws + WS_GSL); short* INV = (short*)(a.ws + WS_INV);
    int* SROW = (int*)(a.ws + WS_SROW);
    LAS unsigned* hist = (LAS unsigned*)F.lds;
    LAS unsigned* sh = hist + 256;
    for (int it = F.c; it < nsets * NE; it += F.G) {
        const int set = it / NE, e = it % NE; const bool isctx = set >= 8; const int n = isctx ? LC : SEQ, cap = isctx ? CAPC : CAPL;
        const float* av = AFF + ((size_t)set * NE + e) * SEQ;
        unsigned v[8]; const bool act = F.tid * 8 < n;
#pragma unroll
        for (int q = 0; q < 8; ++q) v[q] = act ? __float_as_uint(av[F.tid * 8 + q]) : 0u;
        unsigned prefix = 0u, pmask = 0u; int krem = cap;
        for (int pass = 0; pass < 4; ++pass) {
            const int shift = 24 - 8 * pass;
            __syncthreads();
            if (F.tid < 256) hist[F.tid] = 0u;
            __syncthreads();
            if (act) {
#pragma unroll
                for (int q = 0; q < 8; ++q) if ((v[q] & pmask) == prefix) __hip_atomic_fetch_add(&hist[(v[q] >> shift) & 255u], 1u, __ATOMIC_RELAXED, __HIP_MEMORY_SCOPE_WORKGROUP);
            }
            __syncthreads();
            if (F.wave == 0) {
                const u32x4 c4 = *(const LAS u32x4*)(hist + 4 * F.lane); const int tot = (int)(c4.x + c4.y + c4.z + c4.w);
                int incl = tot;
#pragma unroll
                for (int o = 1; o < 64; o <<= 1) { const int t = __builtin_amdgcn_ds_bpermute(((F.lane + o) & 63) << 2, incl); if (F.lane + o < 64) incl += t; }
                const int above = incl - tot;
                if (above < krem && krem <= incl) { int k = krem - above; int bin = 4 * F.lane + 3;
                    if ((int)c4.w < k) { k -= (int)c4.w; bin = 4 * F.lane + 2; if ((int)c4.z < k) { k -= (int)c4.z; bin = 4 * F.lane + 1; if ((int)c4.y < k) { k -= (int)c4.y; bin = 4 * F.lane; } } }
                    sh[0] = (unsigned)bin; sh[1] = (unsigned)k; }
            }
            __syncthreads();
            prefix |= sh[0] << shift; pmask |= 255u << shift; krem = (int)sh[1];
        }
        int ngt = 0, neq = 0;
#pragma unroll
        for (int q = 0; q < 8; ++q) { ngt += (act && v[q] > prefix) ? 1 : 0; neq += (act && v[q] == prefix) ? 1 : 0; }
        unsigned pk = (unsigned)ngt | ((unsigned)neq << 16), incl = pk;
#pragma unroll
        for (int o = 1; o < 64; o <<= 1) { const unsigned t = (unsigned)__builtin_amdgcn_ds_bpermute(((F.lane - o) & 63) << 2, (int)incl); if (F.lane >= o) incl += t; }
        __syncthreads();
        if (F.lane == 63) sh[8 + F.wave] = incl;
        __syncthreads();
        unsigned woff = 0u;
        for (int w = 0; w < F.wave; ++w) woff += sh[8 + w];
        const unsigned excl = incl - pk + woff; int gtb = (int)(excl & 0xffffu), eqb = (int)(excl >> 16);
        const int rowE0 = isctx ? NB * CAPL + (set - 8) * CAPC : set * CAPL; const int mrow0 = isctx ? ML + (set - 8) * LC : set * SEQ;
        if (act) {
#pragma unroll
            for (int q = 0; q < 8; ++q) { const bool gt = v[q] > prefix, eq = v[q] == prefix; const bool sel = gt || (eq && eqb < krem);
                const int pos = gtb + (eqb < krem ? eqb : krem); const int mrow = mrow0 + F.tid * 8 + q;
                if (sel) { SROW[(size_t)e * RPE + rowE0 + pos] = mrow; GSL[(size_t)e * RPE + rowE0 + pos] = __uint_as_float(v[q]); }
                __hip_atomic_store(INV + (size_t)mrow * NE + e, sel ? (short)(rowE0 + pos) : (short)-1, __ATOMIC_RELAXED, __HIP_MEMORY_SCOPE_AGENT);
                gtb += gt ? 1 : 0; eqb += eq ? 1 : 0; }
        }
        __syncthreads();
    }
}

__global__ void __launch_bounds__(512, 2) fwd_kernel(Args a_in) {
    extern __shared__ __attribute__((aligned(16))) unsigned char lds_raw[];
    Frame F; F.lds = (LAS unsigned char*)lds_raw; F.tid = threadIdx.x; F.lane = F.tid & 63; F.wave = __builtin_amdgcn_readfirstlane(F.tid >> 6); F.G = gridDim.x; F.c = blockIdx.x;
    volatile LAS unsigned* MISC = (volatile LAS unsigned*)(F.lds + MISC_OFF);
    if (F.tid < 64) MISC[F.tid] = 0u;
    __syncthreads();
    unsigned* ctl = (unsigned*)(a_in.ws + WS_CTL);
    XcdBarrier bar; bar.bar = ctl + 4096; bar.x = 0; bar.st = nullptr;
    if (N_LAUNCH_MODE == 1) bar = xcd_barrier_post(ctl + 4096, MISC + 8);
    const int lo = a_in.ph_lo, hi = a_in.ph_hi;
#define IN(k) (N_LAUNCH_MODE == 1 || (lo <= (k) && (k) < hi))
#define SEAM(k) do { if (IN(k) && IN((k) + 1)) xcd_barrier(bar, F.wave); } while (0)
    if (IN(0)) { ARGS_HERE; unsigned char* ws = a.ws; float* XC = (float*)(ws + WS_XC); (void)XC; const Frame Fp = fresh_frame(F.lds, F.wave); prologue_misc(Fp, a); convert_weights(Fp, a, 0); __syncthreads(); }
    SEAM(0);
    for (int l = 0; l < DEPTH; ++l) {
        const bool last = (l == DEPTH - 1); const int P0 = 1 + 11 * l;
        const int nrow = last ? ML : MT;
        if (IN(P0)) { ARGS_HERE; unsigned char* ws = a.ws; float* XC = (float*)(ws + WS_XC); (void)XC; const Frame Fp = fresh_frame(F.lds, F.wave); if (l > 0) convert_weights(Fp, a, l); if (l == 0) norm_phase<0>(Fp, a, l, a.out, XC, a.x, a.ctx); else norm_phase<3>(Fp, a, l, a.out, XC, a.out, XC); }
        SEAM(P0);
        if (IN(P0 + 1)) {
            ARGS_HERE; unsigned char* ws = a.ws; float* XC = (float*)(ws + WS_XC); (void)XC; pg8::Geo g{ws + WS_H, ws + WS_WIN, D * 2, D * 2, D * 2};
            pg8::RectSched S; S.init(nrow / 256, 8, F.G, F.c); S.pn_split = 6; S.pn_shift = 6;
            if (!last) { S.nextra = 8 * 4; S.extra_pm0 = ML / 256; S.extra_pn0 = 14; S.extra_nn = 4; }
            EpiWin E{(bf16*)(ws + WS_P), (bf16*)(ws + WS_GB), (bf16*)(ws + WS_Q), (bf16*)(ws + WS_KB), (bf16*)(ws + WS_ZP), (bf16*)(ws + WS_VT), (bf16*)(ws + WS_VTC), (bf16*)(ws + WS_TT), (bf16*)(ws + WS_TTC),
                     a.q_norm_w + (size_t)l * HD, a.k_norm_w + (size_t)l * HD};
            pg8::gemm_phase<EpiWin, pg8::RectSched, true>(F.lds, F.wave, g, S, E);
            pg8::TSched ST{F.G, F.c}; EpiWinT ET{(bf16*)(ws + WS_TT), F.lds + IDX_OFF};
            pg8::gemm_phase<EpiWinT, pg8::TSched, true, false, true>(F.lds, F.wave, g, ST, ET);
            pg8::Geo g8{ws + WS_H8, ws + WS_WQKV8, D, D, D};
            pg8::RectSched S8; S8.init(nrow / 256, 6, F.G, F.c);
            if (last) { S8.nextra = 8 * 4; S8.extra_pm0 = ML / 256; S8.extra_pn0 = 2; S8.extra_nn = 4; }
            else if (F.G == 256) { S8.skew_full = 2; S8.skew_c0 = 96; }
            EpiQKV8 E8{(bf16*)(ws + WS_Q), (bf16*)(ws + WS_KB), (bf16*)(ws + WS_VT), (bf16*)(ws + WS_VTC), a.q_norm_w + (size_t)l * HD, a.k_norm_w + (size_t)l * HD, F.lds + IDX_OFF};
            pg8::gemm_phase<EpiQKV8, pg8::RectSched, true, true>(F.lds, F.wave, g8, S8, E8);
        }
        SEAM(P0 + 1);
        if (IN(P0 + 2)) {
            { ARGS_HERE; unsigned char* ws = a.ws; float* XC = (float*)(ws + WS_XC); (void)XC; const Frame Fp = fresh_frame(F.lds, F.wave); convpool_phase(Fp, a, l, nrow); }
            { ARGS_HERE; unsigned char* ws = a.ws; float* XC = (float*)(ws + WS_XC); (void)XC; const Frame Fp = fresh_frame(F.lds, F.wave); attn_phase(Fp, a, l, !last); }
            { ARGS_HERE; unsigned char* ws = a.ws; float* XC = (float*)(ws + WS_XC); (void)XC; const Frame Fp = fresh_frame(F.lds, F.wave); fft_stage1(Fp, a); }
            if (!last) { ARGS_HERE; unsigned char* ws = a.ws; pg8::Geo g{ws + WS_DFTC, ws + WS_TTC, 4 * LC, 4 * LC, 4 * LC}; pg8::FourierCtxSched S{F.G, F.c}; EpiPlain E{(bf16*)(ws + WS_BR), D, 1024};
              pg8::gemm_phase<EpiPlain, pg8::FourierCtxSched, true>(F.lds, F.wave, g, S, E); }
        }
        SEAM(P0 + 2);
        if (IN(P0 + 3)) { ARGS_HERE; unsigned char* ws = a.ws; float* XC = (float*)(ws + WS_XC); (void)XC; const Frame Fp = fresh_frame(F.lds, F.wave); fft_stage3(Fp, a); }
        SEAM(P0 + 3);
        if (IN(P0 + 4)) {
            ARGS_HERE; unsigned char* ws = a.ws; float* XC = (float*)(ws + WS_XC); (void)XC; pg8::Geo g{ws + WS_BR, ws + WS_WBR, 512 * 2, D * 2, D * 2};
            pg8::BranchSched S{nrow / 256, F.G, F.c};
            EpiPlain E{(bf16*)(ws + WS_PB), 4 * D, 0};
            pg8::gemm_phase<EpiPlain, pg8::BranchSched, true>(F.lds, F.wave, g, S, E);
        }
        SEAM(P0 + 4);
        if (IN(P0 + 5)) {
            ARGS_HERE; unsigned char* ws = a.ws; float* XC = (float*)(ws + WS_XC); (void)XC; pg8::Geo g{ws + WS_H8, ws + WS_WG8, D, D, D};
            pg8::RectSched S; S.init(nrow / 256, 32, F.G, F.c);
            EpiGate E{(const bf16*)(ws + WS_PB), (bf16*)(ws + WS_MG)};
            pg8::gemm_phase<EpiGate, pg8::RectSched, true, true>(F.lds, F.wave, g, S, E);
        }
        SEAM(P0 + 5);
        if (IN(P0 + 6)) {
            ARGS_HERE; unsigned char* ws = a.ws; float* XC = (float*)(ws + WS_XC); (void)XC; pg8::Geo g{ws + WS_MG, ws + WS_WOUT, D * 2, D * 2, D * 2};
            pg8::RectSched S; S.init(nrow / 256, D / 256, F.G, F.c);
            EpiWout E{l == 0 ? a.x : a.out, l == 0 ? a.ctx : XC, a.out, XC, (const float*)(ws + WS_MOD) + (size_t)l * 9 * 6 * D, a.b_ada + (size_t)l * 6 * D};
            pg8::gemm_phase<EpiWout, pg8::RectSched, true>(F.lds, F.wave, g, S, E);
        }
        SEAM(P0 + 6);
        if (IN(P0 + 7)) { ARGS_HERE; unsigned char* ws = a.ws; float* XC = (float*)(ws + WS_XC); (void)XC; const Frame Fp = fresh_frame(F.lds, F.wave); norm_phase<1>(Fp, a, l, a.out, XC, a.out, XC); }
        SEAM(P0 + 7);
        if (IN(P0 + 8)) { ARGS_HERE; unsigned char* ws = a.ws; float* XC = (float*)(ws + WS_XC); (void)XC; const Frame Fp = fresh_frame(F.lds, F.wave); topk_phase(Fp, a, last ? 8 : 16); }
        SEAM(P0 + 8);
        if (IN(P0 + 9)) {
            ARGS_HERE; unsigned char* ws = a.ws; float* XC = (float*)(ws + WS_XC); (void)XC; pg8::Geo g{ws + WS_H, ws + WS_WGU, D, D, D, (const int*)(ws + WS_SROW)};
            pg8::ExpertSched S{last ? 16 : PPE, 16, F.G, F.c};
            EpiGU E{ws + WS_HID};
            pg8::gemm_phase<EpiGU, pg8::ExpertSched, true, true, false, true>(F.lds, F.wave, g, S, E);
        }
        SEAM(P0 + 9);
        if (IN(P0 + 10)) {
            ARGS_HERE; unsigned char* ws = a.ws; float* XC = (float*)(ws + WS_XC); (void)XC; pg8::Geo g{ws + WS_HID, ws + WS_WD, FF, FF, FF};
            pg8::ExpertSched S{last ? 16 : PPE, 8, F.G, F.c};
            EpiY E{(bf16*)(ws + WS_Y)};
            pg8::gemm_phase<EpiY, pg8::ExpertSched, true, true>(F.lds, F.wave, g, S, E);
        }
        SEAM(P0 + 10);
    }
    if (IN(23)) { ARGS_HERE; unsigned char* ws = a.ws; float* XC = (float*)(ws + WS_XC); (void)XC; const Frame Fp = fresh_frame(F.lds, F.wave); norm_phase<2>(Fp, a, DEPTH - 1, a.out, XC, a.out, XC); }
#undef IN
#undef SEAM
}

extern "C" void kernel_launch(void* const* d_in, const int* in_sizes, int n_in, void* d_out, int out_size, void* d_ws, size_t ws_size, hipStream_t stream) {
    static int grid = 0;
    if (grid == 0) {
        if (n_in != 21 || out_size != ML * D || ws_size < WS_END) { fprintf(stderr, "kernel_launch: unexpected shapes (n_in %d out %d ws %zu need %zu)\n", n_in, out_size, ws_size, (size_t)WS_END); grid = -1; return; }
        int dev = 0, cus = 0;
        if (hipGetDevice(&dev) != hipSuccess || hipDeviceGetAttribute(&cus, hipDeviceAttributeMultiprocessorCount, dev) != hipSuccess) { grid = -1; return; }
        if (hipFuncSetAttribute((const void*)fwd_kernel, hipFuncAttributeMaxDynamicSharedMemorySize, LDS_BYTES) != hipSuccess) { fprintf(stderr, "kernel_launch: hipFuncSetAttribute failed\n"); grid = -1; return; }
        int per_cu = 0;
        if (hipOccupancyMaxActiveBlocksPerMultiprocessor(&per_cu, (const void*)fwd_kernel, 512, LDS_BYTES) != hipSuccess || per_cu < 1) fprintf(stderr, "kernel_launch: occupancy query says %d\n", per_cu);
        (void)hipGetLastError();
        grid = cus;
    }
    if (grid < 0) return;
    (void)hipMemsetAsync((char*)d_ws + WS_CTL, 0, ZERO_BYTES, stream);
    Args a{};
    const float** ap = (const float**)&a;
    for (int i = 0; i < 21; ++i) ap[i] = (const float*)d_in[i];
    a.out = (float*)d_out; a.ws = (unsigned char*)d_ws;
    if (N_LAUNCH_MODE == 1) { a.ph_lo = 0; a.ph_hi = NPHASE; hipLaunchKernelGGL(fwd_kernel, dim3(grid), dim3(512), LDS_BYTES, stream, a); }
    else { for (int p = 0; p < NPHASE; ++p) { a.ph_lo = p; a.ph_hi = p + 1; hipLaunchKernelGGL(fwd_kernel, dim3(grid), dim3(512), LDS_BYTES, stream, a); } }
}
```
